# Optimizing an MI355X kernel written in HIP

```python
import jax, jax.numpy as jnp
from jax import lax
import numpy as np

D_MODEL = 1024
BATCH = 2
SEQ = 16384
DEPTH = 1
DEC_BATCH = 32
DEC_SEQ = 32
PAST_LEN = 1024

CHUNK = 64
D_SSM = 1024
SSM_HEAD_DIM = 64
SSM_HEADS = D_SSM // SSM_HEAD_DIM
SSM_GROUPS = 2
SSM_HEADS_PER_GROUP = SSM_HEADS // SSM_GROUPS
SSM_STATE = 128
CONV_W = 4
CONV_DIM = D_SSM + 2 * SSM_GROUPS * SSM_STATE
D_RET = 1024
RET_HEADS = 8
RET_HEAD_DIM = D_RET // RET_HEADS
ROPE_BASE = 10000.0
D_MIX = D_SSM + D_RET
IN_PROJ_DIM = D_SSM + CONV_DIM + SSM_HEADS + 4 * D_RET
D_FF = ((8 * D_MODEL // 3 + 255) // 256) * 256
EPS = 1e-6

kernel_name = "hybrid_ssd_retention_stream_step"


def rms_norm(x, g):
    xf = x.astype(jnp.float32)
    y = xf * lax.rsqrt(jnp.mean(xf * xf, -1, keepdims=True) + EPS)
    return (y * g.astype(jnp.float32)).astype(x.dtype)


def rotary(x, pos):
    half = x.shape[-1] // 2
    inv = ROPE_BASE ** (-jnp.arange(half, dtype=jnp.float32) / half)
    ang = pos.astype(jnp.float32)[:, None] * inv[None, :]
    cos = jnp.cos(ang)[None, :, None, :]
    sin = jnp.sin(ang)[None, :, None, :]
    x1, x2 = x[..., :half], x[..., half:]
    return jnp.concatenate([x1 * cos - x2 * sin, x1 * sin + x2 * cos], -1)


def causal_conv(xbc, conv_state, w, b):
    L = xbc.shape[1]
    xp = jnp.concatenate([conv_state.astype(xbc.dtype), xbc], 1)
    y = sum(xp[:, k:k + L] * w[k] for k in range(CONV_W)) + b
    return jax.nn.silu(y), xp[:, -(CONV_W - 1):]


def ssd_scan(x, dt, a, bm, cm, h0):
    bsz, L = x.shape[:2]
    T = min(CHUNK, L)
    nc = L // T
    G, E, P, N = SSM_GROUPS, SSM_HEADS_PER_GROUP, SSM_HEAD_DIM, SSM_STATE
    x = x.reshape(bsz, nc, T, G, E, P)
    dt = dt.reshape(bsz, nc, T, G, E)
    bm = bm.reshape(bsz, nc, T, G, N)
    cm = cm.reshape(bsz, nc, T, G, N)
    a_cum = jnp.cumsum(dt * a.reshape(G, E), axis=2)
    seg = a_cum[:, :, :, None] - a_cum[:, :, None, :]
    tril = (jnp.arange(T)[:, None] >= jnp.arange(T)[None, :])[:, :, None, None]
    decay = jnp.exp(jnp.where(tril, seg, -jnp.inf))
    cb = jnp.einsum('bclgn,bcsgn->bclsg', cm, bm)
    m = cb[..., None] * decay * dt[:, :, None]
    y_diag = jnp.einsum('bclsge,bcsgep->bclgep', m, x)
    decay_s = jnp.exp(a_cum[:, :, -1:] - a_cum)
    states = jnp.einsum('bcsgn,bcsge,bcsgep->bcgepn', bm, decay_s * dt, x)
    chunk_decay = jnp.exp(a_cum[:, :, -1])

    def step(h, inp):
        s, d = inp
        return h * d[..., None, None] + s, h

    h_last, h_prev = lax.scan(step, h0.reshape(bsz, G, E, P, N),
                              (states.swapaxes(0, 1), chunk_decay.swapaxes(0, 1)))
    h_prev = h_prev.swapaxes(0, 1)
    y_off = jnp.einsum('bclgn,bcgepn,bclge->bclgep', cm, h_prev, jnp.exp(a_cum))
    y = (y_diag + y_off).reshape(bsz, L, SSM_HEADS, P)
    return y, h_last.reshape(bsz, SSM_HEADS, P, N)


def retention_scan(q, k, v, s0):
    bsz, L = q.shape[:2]
    T = min(CHUNK, L)
    nc = L // T
    H, D = RET_HEADS, RET_HEAD_DIM
    q = q.reshape(bsz, nc, T, H, D)
    k = k.reshape(bsz, nc, T, H, D)
    v = v.reshape(bsz, nc, T, H, D)
    lg = jnp.log(1.0 - 2.0 ** (-5.0 - jnp.arange(H, dtype=jnp.float32)))
    idx = jnp.arange(T, dtype=jnp.float32)
    rel = idx[:, None] - idx[None, :]
    causal = (rel >= 0)[..., None]
    dmask = jnp.where(causal, jnp.exp(jnp.where(causal, rel[..., None], 0.0) * lg), 0.0)
    scores = jnp.einsum('bclhd,bcshd->bchls', q, k) * dmask.transpose(2, 0, 1)
    y_in = jnp.einsum('bchls,bcshe->bclhe', scores, v)
    q_decay = jnp.exp((idx + 1.0)[:, None] * lg)
    k_decay = jnp.exp((T - 1.0 - idx)[:, None] * lg)
    chunk_states = jnp.einsum('bcshd,sh,bcshe->bchde', k, k_decay, v)
    chunk_decay = jnp.exp(T * lg)[:, None, None]

    def step(s, cs):
        return s * chunk_decay + cs, s

    s_last, s_prev = lax.scan(step, s0, chunk_states.swapaxes(0, 1))
    s_prev = s_prev.swapaxes(0, 1)
    y_cross = jnp.einsum('bclhd,lh,bchde->bclhe', q, q_decay, s_prev)
    return (y_in + y_cross).reshape(bsz, L, H, D), s_last


def hybrid_layer(x, pos, conv_state, ssm_state, ret_state,
                 n_mix_pre, n_mix_post, n_ffn_pre, n_ffn_post, w_in, conv_w, conv_b,
                 dt_bias, a_log, d_skip, ssm_norm, ret_norm, w_out, w_gate, w_up, w_down):
    bsz, L, _ = x.shape
    h = rms_norm(x, n_mix_pre)
    proj = h @ w_in
    o1 = D_SSM; o2 = o1 + CONV_DIM; o3 = o2 + SSM_HEADS
    o4 = o3 + D_RET; o5 = o4 + D_RET; o6 = o5 + D_RET
    z, xbc, dt_raw, q, k, v, g = jnp.split(proj, [o1, o2, o3, o4, o5, o6], -1)

    xbc, new_conv = causal_conv(xbc, conv_state, conv_w, conv_b)
    xbc = xbc.astype(jnp.float32)
    xs = xbc[..., :D_SSM].reshape(bsz, L, SSM_HEADS, SSM_HEAD_DIM)
    bm = xbc[..., D_SSM:D_SSM + SSM_GROUPS * SSM_STATE].reshape(bsz, L, SSM_GROUPS, SSM_STATE)
    cm = xbc[..., D_SSM + SSM_GROUPS * SSM_STATE:].reshape(bsz, L, SSM_GROUPS, SSM_STATE)
    dt = jax.nn.softplus(dt_raw.astype(jnp.float32) + dt_bias.astype(jnp.float32))
    a = -jnp.exp(a_log.astype(jnp.float32))
    y_ssm, new_ssm = ssd_scan(xs, dt, a, bm, cm, ssm_state.astype(jnp.float32))
    y_ssm = (y_ssm + d_skip.astype(jnp.float32)[:, None] * xs).reshape(bsz, L, D_SSM)
    y_ssm = y_ssm * jax.nn.silu(z.astype(jnp.float32))
    yg = y_ssm.reshape(bsz, L, SSM_GROUPS, D_SSM // SSM_GROUPS)
    yg = yg * lax.rsqrt(jnp.mean(yg * yg, -1, keepdims=True) + EPS)
    y_ssm = yg.reshape(bsz, L, D_SSM) * ssm_norm.astype(jnp.float32)

    qh = rotary(q.astype(jnp.float32).reshape(bsz, L, RET_HEADS, RET_HEAD_DIM), pos)
    kh = rotary(k.astype(jnp.float32).reshape(bsz, L, RET_HEADS, RET_HEAD_DIM), pos) * RET_HEAD_DIM ** -0.5
    vh = v.astype(jnp.float32).reshape(bsz, L, RET_HEADS, RET_HEAD_DIM)
    y_ret, new_ret = retention_scan(qh, kh, vh, ret_state.astype(jnp.float32))
    mu = jnp.mean(y_ret, -1, keepdims=True)
    yc = y_ret - mu
    y_ret = yc * lax.rsqrt(jnp.mean(yc * yc, -1, keepdims=True) + EPS)
    y_ret = y_ret.reshape(bsz, L, D_RET) * ret_norm.astype(jnp.float32) * jax.nn.silu(g.astype(jnp.float32))

    mix = jnp.concatenate([y_ssm, y_ret], -1).astype(x.dtype) @ w_out
    x = x + rms_norm(mix, n_mix_post)

    hf = rms_norm(x, n_ffn_pre)
    ff = (jax.nn.silu(hf @ w_gate) * (hf @ w_up)) @ w_down
    x = x + rms_norm(ff, n_ffn_post)
    return x, new_conv.astype(x.dtype), new_ssm.astype(x.dtype), new_ret.astype(x.dtype)


def setup_inputs(seed: int = 0) -> dict:
    key = jax.random.key(seed)
    ks = jax.random.split(key, 24)
    f32 = jnp.float32
    nrm = lambda k, s, sc: jax.random.normal(k, s, f32) * sc
    dt0 = jnp.exp(jax.random.uniform(ks[9], (DEPTH, SSM_HEADS), f32) * (np.log(0.1) - np.log(0.001)) + np.log(0.001))
    return {
        "x_prompt": nrm(ks[0], (BATCH, SEQ, D_MODEL), 1.0),
        "x_sample": nrm(ks[1], (DEC_BATCH, DEC_SEQ, D_MODEL), 1.0),
        "state_conv": nrm(ks[2], (DEPTH, DEC_BATCH, CONV_W - 1, CONV_DIM), 1.0),
        "state_ssm": nrm(ks[3], (DEPTH, DEC_BATCH, SSM_HEADS, SSM_HEAD_DIM, SSM_STATE), 0.1),
        "state_ret": nrm(ks[4], (DEPTH, DEC_BATCH, RET_HEADS, RET_HEAD_DIM, RET_HEAD_DIM), 0.5),
        "n_mix_pre": 1.0 + nrm(ks[5], (DEPTH, D_MODEL), 0.05),
        "n_mix_post": 1.0 + nrm(ks[6], (DEPTH, D_MODEL), 0.05),
        "n_ffn_pre": 1.0 + nrm(ks[7], (DEPTH, D_MODEL), 0.05),
        "n_ffn_post": 1.0 + nrm(ks[8], (DEPTH, D_MODEL), 0.05),
        "w_in": nrm(ks[10], (DEPTH, D_MODEL, IN_PROJ_DIM), D_MODEL ** -0.5),
        "conv_w": nrm(ks[11], (DEPTH, CONV_W, CONV_DIM), CONV_W ** -0.5),
        "conv_b": nrm(ks[12], (DEPTH, CONV_DIM), 0.02),
        "dt_bias": dt0 + jnp.log(-jnp.expm1(-dt0)),
        "a_log": jnp.log(jax.random.uniform(ks[13], (DEPTH, SSM_HEADS), f32, 1.0, 16.0)),
        "d_skip": 1.0 + nrm(ks[14], (DEPTH, SSM_HEADS), 0.1),
        "ssm_norm": 1.0 + nrm(ks[15], (DEPTH, D_SSM), 0.05),
        "ret_norm": 1.0 + nrm(ks[16], (DEPTH, D_RET), 0.05),
        "w_out": nrm(ks[17], (DEPTH, D_MIX, D_MODEL), D_MIX ** -0.5),
        "w_gate": nrm(ks[18], (DEPTH, D_MODEL, D_FF), D_MODEL ** -0.5),
        "w_up": nrm(ks[19], (DEPTH, D_MODEL, D_FF), D_MODEL ** -0.5),
        "w_down": nrm(ks[20], (DEPTH, D_FF, D_MODEL), D_FF ** -0.5),
    }


def reference(x_prompt, x_sample, state_conv, state_ssm, state_ret,
              n_mix_pre, n_mix_post, n_ffn_pre, n_ffn_post, w_in, conv_w, conv_b,
              dt_bias, a_log, d_skip, ssm_norm, ret_norm, w_out, w_gate, w_up, w_down):
    bp, lp = x_prompt.shape[:2]
    ls = x_sample.shape[1]
    pos_p = jnp.arange(lp)
    pos_s = PAST_LEN + jnp.arange(ls)
    yp, ys = x_prompt, x_sample
    conv_p, ssm_p, ret_p, conv_s, ssm_s, ret_s = [], [], [], [], [], []
    for l in range(DEPTH):
        w = (n_mix_pre[l], n_mix_post[l], n_ffn_pre[l], n_ffn_post[l], w_in[l], conv_w[l], conv_b[l],
             dt_bias[l], a_log[l], d_skip[l], ssm_norm[l], ret_norm[l], w_out[l], w_gate[l], w_up[l], w_down[l])
        zc = jnp.zeros((bp, CONV_W - 1, CONV_DIM), yp.dtype)
        zs = jnp.zeros((bp, SSM_HEADS, SSM_HEAD_DIM, SSM_STATE), jnp.float32)
        zr = jnp.zeros((bp, RET_HEADS, RET_HEAD_DIM, RET_HEAD_DIM), jnp.float32)
        yp, c1, s1, r1 = hybrid_layer(yp, pos_p, zc, zs, zr, *w)
        ys, c2, s2, r2 = hybrid_layer(ys, pos_s, state_conv[l], state_ssm[l], state_ret[l], *w)
        conv_p.append(c1); ssm_p.append(s1); ret_p.append(r1)
        conv_s.append(c2); ssm_s.append(s2); ret_s.append(r2)
    return (yp, ys, jnp.stack(conv_p), jnp.stack(ssm_p), jnp.stack(ret_p),
            jnp.stack(conv_s), jnp.stack(ssm_s), jnp.stack(ret_s))
```

```cpp
#include <hip/hip_runtime.h>
#include <cstdio>
#include <cstdint>
namespace pg8 {
#define PG8_LAS __attribute__((address_space(3)))
typedef unsigned short bf16_t;
typedef short bf16x8 __attribute__((ext_vector_type(8)));
typedef float f32x4 __attribute__((ext_vector_type(4)));
typedef unsigned u32x4 __attribute__((ext_vector_type(4)));
constexpr int BM = 256, BK = 64, HALF = 128, HTB = HALF * BK * 2  , STAGE_BYTES = 8 * HTB, NXCD = 8, WGM = 8;

__host__ __device__ __forceinline__ int lds_byte(int r, int c) { const int st = (r >> 4) * 2 + (c >> 5), rr = r & 15, cc = c & 31, ob = rr * 64 + cc * 2; return st * 1024 + (ob ^ (((ob >> 9) & 1) << 5)); }
__host__ __device__ __forceinline__ void stage_rc(int b, int& R, int& C) { const int st = b / 1024, sb = b % 1024, swz = sb ^ (((sb >> 9) & 1) << 5); R = (st >> 1) * 16 + swz / 64; C = (st & 1) * 32 + (swz % 64) / 2; }
__host__ __device__ __forceinline__ int perm32(int rho) { const int n = rho >> 4, i = rho & 15; return 8 * (i >> 2) + 4 * n + (i & 3); }

struct Unit { int pm, pn; };
struct Gemm { const bf16_t* A; const bf16_t* Bt; int M, N, K, lda; };

struct StaticOrder {
    int nM, nN, nwg, G, c;
    __host__ __device__ void init(int M, int N, int G_, int c_) { nM = M / BM; nN = N / BM; nwg = nM * nN; G = G_; c = c_; }
    __host__ __device__ bool next(int i, Unit& u) const {
        const long L = (long)i * G + c; if (L >= nwg) return false;
        int wgid = (int)L; { const int q = nwg / NXCD, r = nwg % NXCD, xcd = wgid % NXCD, off = wgid / NXCD; wgid = (xcd < r ? xcd * (q + 1) : r * (q + 1) + (xcd - r) * q) + off; }
        const int nig = WGM * nN, gid = wgid / nig, fm = gid * WGM, gsz = (nM - fm) < WGM ? (nM - fm) : WGM;
        u.pm = fm + ((wgid % nig) % gsz); u.pn = (wgid % nig) / gsz; return true;
    }
    __device__ __forceinline__ void a_ready(const Unit&) const {}
    __device__ __forceinline__ void done(const Unit&) const {}
};

__device__ __forceinline__ unsigned cvt_pk_bf16(float lo, float hi) { unsigned r; asm volatile("v_cvt_pk_bf16_f32 %0, %1, %2" : "=v"(r) : "v"(lo), "v"(hi)); return r; }
struct EpiBf16 {
    static constexpr bool PERM = true, AFTER_DRAIN = false;
    bf16_t* O; int ldc;
    __device__ __forceinline__ void operator()(const f32x4 (&acc)[2][2][4][2], const Unit& u, int wr, int wc, int fr, int fq) const {
        const int row0 = u.pm * BM + wr * 64 + fr; const int col0 = u.pn * BM + wc * 32 + 8 * fq;
#pragma unroll
        for (int ai = 0; ai < 2; ++ai)
#pragma unroll
            for (int m = 0; m < 4; ++m) { bf16_t* rowp = O + (size_t)(row0 + ai * HALF + m * 16) * ldc + col0;
#pragma unroll
                for (int bj = 0; bj < 2; ++bj) { const f32x4 v0 = acc[ai][bj][m][0], v1 = acc[ai][bj][m][1];
                    u32x4 w; w.x = cvt_pk_bf16(v0[0], v0[1]); w.y = cvt_pk_bf16(v0[2], v0[3]); w.z = cvt_pk_bf16(v1[0], v1[1]); w.w = cvt_pk_bf16(v1[2], v1[3]);
                    *(u32x4*)(rowp + bj * HALF) = w; } }
    }
};
struct EpiF32 {
    static constexpr bool PERM = false, AFTER_DRAIN = false;
    float* C; int ldc;
    __device__ __forceinline__ void operator()(const f32x4 (&acc)[2][2][4][2], const Unit& u, int wr, int wc, int fr, int fq) const {
        const int row0 = u.pm * BM + wr * 64 + fr, col0 = u.pn * BM + wc * 32 + 4 * fq;
#pragma unroll
        for (int ai = 0; ai < 2; ++ai)
#pragma unroll
            for (int m = 0; m < 4; ++m) { float* rowp = C + (size_t)(row0 + ai * HALF + m * 16) * ldc + col0;
#pragma unroll
                for (int bj = 0; bj < 2; ++bj)
#pragma unroll
                    for (int n = 0; n < 2; ++n) *(f32x4*)(rowp + bj * HALF + n * 16) = acc[ai][bj][m][n]; }
    }
};
__device__ __forceinline__ float silu_f(float x) { return x * __builtin_amdgcn_rcpf(1.0f + __builtin_amdgcn_exp2f(-1.4426950408889634f * x)); }
struct EpiSwiGLU {
    static constexpr bool PERM = true, AFTER_DRAIN = false;
    bf16_t* O; int ldc;
    __device__ __forceinline__ void operator()(const f32x4 (&acc)[2][2][4][2], const Unit& u, int wr, int wc, int fr, int fq) const {
        const int row0 = u.pm * BM + wr * 64 + fr; const int col0 = u.pn * HALF + wc * 32 + 8 * fq;
#pragma unroll
        for (int ai = 0; ai < 2; ++ai)
#pragma unroll
            for (int m = 0; m < 4; ++m) { bf16_t* rowp = O + (size_t)(row0 + ai * HALF + m * 16) * ldc + col0;
                const f32x4 g0 = acc[ai][0][m][0], g1 = acc[ai][0][m][1], u0 = acc[ai][1][m][0], u1 = acc[ai][1][m][1];
                u32x4 w; w.x = cvt_pk_bf16(silu_f(g0[0]) * u0[0], silu_f(g0[1]) * u0[1]); w.y = cvt_pk_bf16(silu_f(g0[2]) * u0[2], silu_f(g0[3]) * u0[3]);
                w.z = cvt_pk_bf16(silu_f(g1[0]) * u1[0], silu_f(g1[1]) * u1[1]); w.w = cvt_pk_bf16(silu_f(g1[2]) * u1[2], silu_f(g1[3]) * u1[3]);
                *(u32x4*)rowp = w; }
    }
};

template <class Epi, class Sched, bool ALIGN_EPI = false, bool SP2 = false>
__device__ __forceinline__ void gemm_phase(PG8_LAS unsigned char* lds, const Gemm g, const Sched& S, const Epi& E) {
    const int tid = threadIdx.x, wid = __builtin_amdgcn_readfirstlane(tid >> 6), lane = tid & 63, wr = wid >> 2, wc = wid & 3, fr = lane & 15, fq = lane >> 4;
    const int K = g.K, nt = K / BK;
    unsigned voffA[2], voffB[2];
#pragma unroll
    for (int i = 0; i < 2; ++i) { int R, C; stage_rc(tid * 16 + i * 8192, R, C); const int Rb = Epi::PERM ? ((R & ~31) + perm32(R & 31)) : R;
        voffA[i] = (unsigned)(R * g.lda + C) * 2u; voffB[i] = (unsigned)(Rb * K + C) * 2u; }
    const size_t kstep = (size_t)(BK * 2);
    const size_t hstepA = (size_t)HALF * g.lda * 2, hstepB = (size_t)HALF * K * 2;
    const size_t tstepA = 2 * hstepA, tstepB = 2 * hstepB;
    const unsigned ldsw = (unsigned)wid * 1024u;
    const int aoff = lds_byte(wr * 64 + fr, fq * 8), boff = lds_byte(wc * 32 + fr, fq * 8);
#define PG8_SA(b, h) (((b) * 2 + (h)) * HTB)
#define PG8_SB(b, h) ((4 + (b) * 2 + (h)) * HTB)
#define PG8_STAGE(bufoff, gbase, voff) do { _Pragma("unroll") for (int _i = 0; _i < 2; ++_i) \
        __builtin_amdgcn_global_load_lds((const unsigned*)((const char*)(gbase) + (voff)[_i]), (PG8_LAS unsigned*)(lds + (bufoff) + ldsw + _i * 8192), 16, 0, 0); } while (0)
#define PG8_LDA(dst, b, h) do { _Pragma("unroll") for (int m = 0; m < 4; ++m) _Pragma("unroll") for (int k = 0; k < 2; ++k) dst[m][k] = *(const PG8_LAS bf16x8*)(lds + PG8_SA(b, h) + aoff + m * 2048 + k * 1024); } while (0)
#define PG8_LDB(dst, b, h) do { _Pragma("unroll") for (int n = 0; n < 2; ++n) _Pragma("unroll") for (int k = 0; k < 2; ++k) dst[n][k] = *(const PG8_LAS bf16x8*)(lds + PG8_SB(b, h) + boff + n * 2048 + k * 1024); } while (0)
#define PG8_MMA(ai, bj, At, Bt) do { __builtin_amdgcn_s_setprio(1); _Pragma("unroll") for (int m = 0; m < 4; ++m) _Pragma("unroll") for (int n = 0; n < 2; ++n) _Pragma("unroll") for (int k = 0; k < 2; ++k) \
        acc[ai][bj][m][n] = __builtin_amdgcn_mfma_f32_16x16x32_bf16(Bt[n][k], At[m][k], acc[ai][bj][m][n], 0, 0, 0); __builtin_amdgcn_s_setprio(0); } while (0)
#define PG8_WAIT_V(n) asm volatile("s_waitcnt vmcnt(" #n ")" ::: "memory")
#define PG8_WAIT_L(n) asm volatile("s_waitcnt lgkmcnt(" #n ")" ::: "memory")
#define PG8_BAR __builtin_amdgcn_s_barrier()
#define PG8_SCHED __builtin_amdgcn_sched_barrier(0)
    Unit cur, nxt; int ui = 0;
    if (!S.next(0, cur)) return;
    f32x4 acc[2][2][4][2];
#pragma unroll
    for (int a = 0; a < 2; ++a)
#pragma unroll
        for (int b = 0; b < 2; ++b)
#pragma unroll
            for (int m = 0; m < 4; ++m)
#pragma unroll
                for (int n = 0; n < 2; ++n) acc[a][b][m][n] = (f32x4){0.f, 0.f, 0.f, 0.f};
    bf16x8 At[4][2], B0[2][2], B1[2][2];
    const char* cA = (const char*)g.A + (size_t)cur.pm * tstepA; const char* cB = (const char*)g.Bt + (size_t)cur.pn * tstepB;
    S.a_ready(cur);
    if constexpr (SP2) {
        PG8_STAGE(PG8_SB(0, 0), cB, voffB); PG8_STAGE(PG8_SB(0, 1), cB + hstepB, voffB); PG8_STAGE(PG8_SA(0, 0), cA, voffA); PG8_STAGE(PG8_SA(0, 1), cA + hstepA, voffA);
        if (wr == 1) PG8_BAR;
        PG8_WAIT_V(2); PG8_BAR;
        PG8_STAGE(PG8_SB(1, 0), cB + kstep, voffB); PG8_STAGE(PG8_SA(1, 0), cA + kstep, voffA); PG8_STAGE(PG8_SB(1, 1), cB + hstepB + kstep, voffB);
        PG8_WAIT_V(6); PG8_BAR;
    } else {
        PG8_STAGE(PG8_SB(0, 0), cB, voffB); PG8_STAGE(PG8_SA(0, 0), cA, voffA); PG8_STAGE(PG8_SB(0, 1), cB + hstepB, voffB); PG8_STAGE(PG8_SA(0, 1), cA + hstepA, voffA);
        if (wr == 1) PG8_BAR;
        PG8_WAIT_V(4); PG8_BAR;
        PG8_STAGE(PG8_SB(1, 0), cB + kstep, voffB); PG8_STAGE(PG8_SA(1, 0), cA + kstep, voffA); PG8_STAGE(PG8_SB(1, 1), cB + hstepB + kstep, voffB);
        PG8_WAIT_V(6); PG8_BAR;
    }
    for (;;) {
        const bool has_next = S.next(ui + 1, nxt);
        const char* nA = has_next ? (const char*)g.A + (size_t)nxt.pm * tstepA : cA; const char* nB = has_next ? (const char*)g.Bt + (size_t)nxt.pn * tstepB : cB;
        for (int t = 0; t < nt; t += 2) {
            const bool last = (t == nt - 2);
            const char* a1 = cA + (size_t)(t + 1) * kstep;
            const char* a2 = last ? nA : cA + (size_t)(t + 2) * kstep; const char* b2 = last ? nB : cB + (size_t)(t + 2) * kstep;
            const char* a3 = a2 + kstep; const char* b3 = b2 + kstep;
            if (last && has_next) S.a_ready(nxt);
            if constexpr (SP2) {
            PG8_LDB(B0, 0, 0); PG8_LDB(B1, 0, 1); PG8_SCHED; PG8_LDA(At, 0, 0); PG8_STAGE(PG8_SA(1, 1), a1 + hstepA, voffA);
            PG8_WAIT_V(8); PG8_WAIT_L(0); PG8_BAR; PG8_MMA(0, 0, At, B0); PG8_MMA(0, 1, At, B1); PG8_BAR; PG8_SCHED;
            PG8_LDA(At, 0, 1); PG8_STAGE(PG8_SB(0, 0), b2, voffB); PG8_STAGE(PG8_SB(0, 1), b2 + hstepB, voffB); PG8_STAGE(PG8_SA(0, 0), a2, voffA);
            PG8_WAIT_V(8); PG8_WAIT_L(0); PG8_BAR; PG8_MMA(1, 0, At, B0); PG8_MMA(1, 1, At, B1); PG8_BAR; PG8_SCHED;
            PG8_LDB(B0, 1, 0); PG8_LDB(B1, 1, 1); PG8_SCHED; PG8_LDA(At, 1, 0); PG8_STAGE(PG8_SA(0, 1), a2 + hstepA, voffA);
            PG8_WAIT_V(8); PG8_WAIT_L(0); PG8_BAR; PG8_MMA(0, 0, At, B0); PG8_MMA(0, 1, At, B1); PG8_BAR; PG8_SCHED;
            PG8_LDA(At, 1, 1); PG8_STAGE(PG8_SB(1, 0), b3, voffB); PG8_STAGE(PG8_SB(1, 1), b3 + hstepB, voffB); PG8_STAGE(PG8_SA(1, 0), a3, voffA);
            PG8_WAIT_V(8); PG8_WAIT_L(0); PG8_BAR; PG8_MMA(1, 0, At, B0); PG8_MMA(1, 1, At, B1); PG8_BAR; PG8_SCHED;
            } else {
            PG8_LDB(B0, 0, 0); PG8_SCHED; PG8_LDA(At, 0, 0); PG8_STAGE(PG8_SA(1, 1), a1 + hstepA, voffA);
            PG8_WAIT_L(8); PG8_BAR; PG8_WAIT_L(0); PG8_MMA(0, 0, At, B0); PG8_BAR; PG8_SCHED;
            PG8_LDB(B1, 0, 1); PG8_STAGE(PG8_SB(0, 0), b2, voffB);
            PG8_BAR; PG8_WAIT_L(0); PG8_MMA(0, 1, At, B1); PG8_BAR;
            PG8_LDA(At, 0, 1); PG8_STAGE(PG8_SA(0, 0), a2, voffA);
            PG8_BAR; PG8_WAIT_L(0); PG8_MMA(1, 0, At, B0); PG8_BAR; PG8_SCHED;
            PG8_STAGE(PG8_SB(0, 1), b2 + hstepB, voffB);
            PG8_WAIT_V(6); PG8_BAR; PG8_MMA(1, 1, At, B1); PG8_BAR;
            PG8_LDB(B0, 1, 0); PG8_SCHED; PG8_LDA(At, 1, 0); PG8_STAGE(PG8_SA(0, 1), a2 + hstepA, voffA);
            PG8_WAIT_L(8); PG8_BAR; PG8_WAIT_L(0); PG8_MMA(0, 0, At, B0); PG8_BAR; PG8_SCHED;
            PG8_LDB(B1, 1, 1); PG8_STAGE(PG8_SB(1, 0), b3, voffB);
            PG8_BAR; PG8_WAIT_L(0); PG8_MMA(0, 1, At, B1); PG8_BAR;
            PG8_LDA(At, 1, 1); PG8_STAGE(PG8_SA(1, 0), a3, voffA);
            PG8_BAR; PG8_WAIT_L(0); PG8_MMA(1, 0, At, B0); PG8_BAR; PG8_SCHED;
            PG8_STAGE(PG8_SB(1, 1), b3 + hstepB, voffB);
            PG8_WAIT_V(6); PG8_BAR; PG8_MMA(1, 1, At, B1); PG8_BAR;
            }
        }
        if constexpr (ALIGN_EPI) { if (wr == 0) PG8_BAR; }
        if constexpr (!Epi::AFTER_DRAIN) { E(acc, cur, wr, wc, fr, fq); S.done(cur); }
        if (!has_next) break;
#pragma unroll
        for (int a = 0; a < 2; ++a)
#pragma unroll
            for (int b = 0; b < 2; ++b)
#pragma unroll
                for (int m = 0; m < 4; ++m)
#pragma unroll
                    for (int n = 0; n < 2; ++n) acc[a][b][m][n] = (f32x4){0.f, 0.f, 0.f, 0.f};
        cur = nxt; cA = nA; cB = nB; ++ui;
        if constexpr (ALIGN_EPI) { if (wr == 1) PG8_BAR; }
    }
    PG8_WAIT_V(0);
    if constexpr (!ALIGN_EPI) { if (wr == 0) PG8_BAR; }
    PG8_BAR;
    if constexpr (Epi::AFTER_DRAIN) { E.fused(acc, cur, wr, wc, fr, fq, lds, wid, lane); S.done(cur); }
#undef PG8_SA
#undef PG8_SB
#undef PG8_STAGE
#undef PG8_LDA
#undef PG8_LDB
#undef PG8_MMA
#undef PG8_WAIT_V
#undef PG8_WAIT_L
#undef PG8_BAR
#undef PG8_SCHED
}
}

#define GAS __attribute__((address_space(1)))
#define LAS __attribute__((address_space(3)))
typedef unsigned short bf16;
typedef unsigned v4u __attribute__((ext_vector_type(4)));
typedef float f32x4 __attribute__((ext_vector_type(4)));
typedef short bf16x8 __attribute__((ext_vector_type(8)));
typedef GAS unsigned gu32;
typedef GAS unsigned long long gu64;
#define RLX_AGENT __ATOMIC_RELAXED, __HIP_MEMORY_SCOPE_AGENT
#define LDS_WAIT() asm volatile("s_waitcnt lgkmcnt(0)" ::: "memory")
#define VM_WAIT() asm volatile("s_waitcnt vmcnt(0)" ::: "memory")
__device__ __forceinline__ unsigned long long rt() { return __builtin_amdgcn_s_memrealtime(); }
__device__ __forceinline__ unsigned f2bf(float f) { unsigned u = __builtin_bit_cast(unsigned, f); return (u + 0x7fffu + ((u >> 16) & 1u)) >> 16; }
__device__ __forceinline__ unsigned pk2(float lo, float hi) { return f2bf(lo) | (f2bf(hi) << 16); }

#define XB_TMO      128
#define XB_XCNT(j)  (256  + 64 * (j))
#define XB_XSUB(j)  (1280 + 64 * (j))
#define XB_XGEN(j)  (2304 + 64 * (j))
#define XB_TOP      3328
#define XB_TOPGEN   3392
#define XCD_BAR_WORDS 3456
#define XB_SPIN_CAP (1u << 18)

__device__ __forceinline__ unsigned xb_ld(unsigned* p)              { return __hip_atomic_load(p, __ATOMIC_RELAXED, __HIP_MEMORY_SCOPE_AGENT); }
__device__ __forceinline__ unsigned xb_add(unsigned* p, unsigned v) { return __hip_atomic_fetch_add(p, v, __ATOMIC_RELAXED, __HIP_MEMORY_SCOPE_AGENT); }
__device__ __forceinline__ unsigned xb_xcc_id() { return (unsigned)__builtin_amdgcn_s_getreg((3 << 11) | 20) & 0xFu; }
#define XB_SPIN(cond, bar) do { unsigned _sp = 0; while (cond) { __builtin_amdgcn_s_sleep(1); \
    if ((++_sp & 255u) == 0u) { if (xb_ld(&(bar)[XB_TMO])) break; if (_sp > XB_SPIN_CAP) { atomicAdd(&(bar)[XB_TMO], 1u); break; } } } } while (0)

struct XcdBarrier {
    unsigned* bar; unsigned x;
    volatile LAS unsigned* st;
};

__device__ __forceinline__ XcdBarrier xcd_barrier_post(unsigned* bar, volatile LAS unsigned* st) {
    XcdBarrier b; b.bar = bar; b.x = xb_xcc_id(); b.st = st;
    if (threadIdx.x == 0) (void)xb_add(&bar[XB_XCNT(b.x)], 1u);
    return b;
}
__device__ __forceinline__ void xcd_barrier_complete(unsigned* bar, unsigned x, unsigned& nloc, unsigned& nx) {
    const unsigned G = gridDim.x * gridDim.y * gridDim.z;
    unsigned sum, cnt, mine, sp = 0u;
    for (;;) {
        sum = 0u; cnt = 0u; mine = 0u;
#pragma unroll
        for (unsigned j = 0; j < 16; ++j) { const unsigned c = xb_ld(&bar[XB_XCNT(j)]); sum += c; cnt += (c > 0u) ? 1u : 0u; mine = (j == x) ? c : mine; }
        if (sum == G) break;
        __builtin_amdgcn_s_sleep(1);
        if ((++sp & 255u) == 0u) { if (xb_ld(&bar[XB_TMO])) break; if (sp > XB_SPIN_CAP) { atomicAdd(&bar[XB_TMO], 1u); break; } }
    }
    nloc = mine > 0u ? mine : 1u; nx = cnt > 0u ? cnt : 1u;
}

__device__ __forceinline__ void xcd_barrier(const XcdBarrier& b) {
    asm volatile("s_waitcnt vmcnt(0)" ::: "memory");
    __syncthreads();
    if (threadIdx.x == 0) {
        unsigned* bar = b.bar;
        __builtin_amdgcn_s_waitcnt(0);
        unsigned nloc = b.st[0], nx = b.st[1];
        if (nloc == 0u) { xcd_barrier_complete(bar, b.x, nloc, nx); b.st[0] = nloc; b.st[1] = nx; }
        const unsigned old = xb_add(&bar[XB_XSUB(b.x)], 1u);
        const unsigned gen = old / nloc;
        if (old + 1u == (gen + 1u) * nloc) {
            __builtin_amdgcn_fence(__ATOMIC_RELEASE, "agent");
            asm volatile("s_waitcnt vmcnt(0)" ::: "memory");
            const unsigned og = xb_add(&bar[XB_TOP], 1u);
            const unsigned tg = og / nx;
            if (og + 1u == (tg + 1u) * nx) xb_add(&bar[XB_TOPGEN], 1u);
            else XB_SPIN(xb_ld(&bar[XB_TOPGEN]) == tg, bar);
            __builtin_amdgcn_fence(__ATOMIC_ACQUIRE, "agent");
            xb_add(&bar[XB_XGEN(b.x)], 1u);
            asm volatile("s_waitcnt vmcnt(0)" ::: "memory");
        } else {
            XB_SPIN(xb_ld(&bar[XB_XGEN(b.x)]) == gen, bar);
            __builtin_amdgcn_fence(__ATOMIC_ACQUIRE, "agent");
            asm volatile("s_waitcnt vmcnt(0)" ::: "memory");
        }
    }
    __syncthreads();
}


constexpr int NWAVES = 8, NTHR = 512;
constexpr int DM = 1024, PB = 2, PL = 16384, SBN = 32, SL = 32, PASTLEN = 1024;
constexpr int RP = PB * PL;
constexpr int RS = SBN * SL;
constexpr int RT = RP + RS;
constexpr int NPANEL = RT / 256, NPP = RP / 256;
constexpr int DSSM = 1024, NH = 16, HP = 64, NG = 2, NST = 128, CONVD = 1536;
constexpr int DRET = 1024, RH = 8, RD = 128;
constexpr int DFF = 2816, NIN = 6672;
constexpr int LP = 6912, Z0 = 0, G0 = 1024, XBC0 = 2048, XB0 = XBC0 + 1024, XC0 = XBC0 + 1280, Q0 = 3584, K0 = 4608, V0 = 5632, DT0 = 6656;
constexpr int HF0 = 2048;
constexpr int ACT0 = 3072;
constexpr int RAW2_0 = 3584;
constexpr float EPS = 1e-6f;

constexpr size_t MiB = 1u << 20;
constexpr size_t WS_CTL = 0, CTL_ZERO_BYTES = 1 * MiB;
constexpr size_t WS_W1 = 1 * MiB;
constexpr size_t WS_W2 = 16 * MiB;
constexpr size_t WS_W3 = 20 * MiB;
constexpr size_t WS_W4 = 31 * MiB;
constexpr size_t WS_MISC = 37 * MiB;
constexpr size_t WS_PROJ = 48 * MiB;
constexpr size_t WS_END = WS_PROJ + (size_t)RT * LP * 2;
static_assert(WS_END <= 512 * MiB, "d_ws map");
constexpr size_t MS_SSQ = 0;
constexpr size_t MS_DEC = MS_SSQ + (size_t)RT * 16;
constexpr size_t MS_END = MS_DEC + (size_t)NPP * 16;
static_assert(MS_END * 4 <= 11 * MiB, "misc map");
constexpr size_t O_YP = 0, O_YS = (size_t)RP * DM, O_CP = O_YS + (size_t)RS * DM, O_SP = O_CP + (size_t)PB * 3 * CONVD, O_RP = O_SP + (size_t)PB * NH * HP * NST,
                 O_CS = O_RP + (size_t)PB * RH * RD * RD, O_SS = O_CS + (size_t)SBN * 3 * CONVD, O_RS = O_SS + (size_t)SBN * NH * HP * NST, O_END = O_RS + (size_t)SBN * RH * RD * RD;
static_assert(O_END == 43672576, "d_out map");
constexpr size_t ST_SSD = 0;
constexpr size_t ST_RET = (size_t)NPP * NH * NST * HP;
static_assert(ST_RET + (size_t)NPP * RH * RD * RD <= (size_t)RT * DM, "state scratch fits the y region");

constexpr int CW_TMO = 0, CW_CODE = 1;
constexpr int CW_BAR = 4096;

constexpr int RING_OFF = 0, RING_BYTES = 131072;
constexpr int LDSCTL_OFF = RING_BYTES, MISC_OFF = LDSCTL_OFF + 320;
constexpr int LDS_BYTES = 147456;
static_assert(MISC_OFF + 128 <= LDS_BYTES, "LDS map");

struct Frame {
    LAS unsigned char* lds;
    volatile LAS unsigned* MISC;
    gu32* ctl;
    int tid, lane, wave;
    int vcu, G;
    const float *xp, *xs, *st_conv, *st_ssm, *st_ret, *n_mix_pre, *n_mix_post, *n_ffn_pre, *n_ffn_post, *w_in, *conv_w, *conv_b, *dt_bias, *a_log, *d_skip, *ssm_norm, *ret_norm, *w_out, *w_gate, *w_up, *w_down;
    float* out;
    bf16 *W1t, *W2t, *W3t, *W4t, *PROJ, *HB;
    float* misc;
};
__device__ __forceinline__ float wave_sum(float v) {
#pragma unroll
    for (int o = 1; o < 64; o <<= 1) v += __shfl_xor(v, o);
    return v;
}
__device__ __forceinline__ const float* x_row(const Frame& F, int r) { return r < RP ? F.xp + (size_t)r * DM : F.xs + (size_t)(r - RP) * DM; }

__device__ __forceinline__ int dst_row(int mode, int n) {
    if (mode == 1) {
        if (n < 1024) return Z0 + n;
        if (n < 2560) return XBC0 + (n - 1024);
        if (n < 2576) return DT0 + (n - 2560);
        if (n < 3600) return Q0 + (n - 2576);
        if (n < 4624) return K0 + (n - 3600);
        if (n < 5648) return V0 + (n - 4624);
        return G0 + (n - 5648);
    }
    if (mode == 2) return 256 * (n >> 7) + (n & 127);
    if (mode == 3) return 256 * (n >> 7) + 128 + (n & 127);
    return n;
}
__device__ __forceinline__ void p0_transpose_item(const float* W, int K, int N, bf16* WT, int mode, const float* ks0, const float* ks1, int ksplit, LAS float* scr, int item, int lane) {
    const int nblk = (N + 31) / 32, kb = item / nblk, nb = item % nblk, k0 = 64 * kb, n0 = 32 * nb;
    const int nn = n0 + (lane & 31);
#pragma unroll 8
    for (int i = 0; i < 32; ++i) { const int kk = 2 * i + (lane >> 5); scr[kk * 33 + (lane & 31)] = (nn < N) ? W[(size_t)(k0 + kk) * N + nn] : 0.f; }
    LDS_WAIT(); asm volatile("" ::: "memory");
    const int c = lane & 7;
    float sc[8];
#pragma unroll
    for (int i = 0; i < 8; ++i) { const int k = k0 + 8 * c + i; sc[i] = ks0 ? (k < ksplit ? ks0[k] : ks1[k - ksplit]) : 1.f; }
#pragma unroll
    for (int j = 0; j < 4; ++j) { const int n = (lane >> 3) + 8 * j; const LAS float* s = scr + (8 * c) * 33 + n;
        v4u o; o.x = pk2(s[0 * 33] * sc[0], s[1 * 33] * sc[1]); o.y = pk2(s[2 * 33] * sc[2], s[3 * 33] * sc[3]); o.z = pk2(s[4 * 33] * sc[4], s[5 * 33] * sc[5]); o.w = pk2(s[6 * 33] * sc[6], s[7 * 33] * sc[7]);
        if (n0 + n < N) *(GAS v4u*)(WT + (size_t)dst_row(mode, n0 + n) * K + k0 + 8 * c) = o; }
    LDS_WAIT(); asm volatile("" ::: "memory");
}
__device__ __forceinline__ void rms_row_to_bf16(const Frame& F, const float* xrow, bf16* orow) {
    const GAS f32x4* xr = (const GAS f32x4*)xrow + F.lane;
    f32x4 v[4]; float s2 = 0.f;
#pragma unroll
    for (int j = 0; j < 4; ++j) { v[j] = xr[64 * j]; s2 += (v[j].x * v[j].x + v[j].y * v[j].y) + (v[j].z * v[j].z + v[j].w * v[j].w); }
    const float rs = 1.0f / sqrtf(wave_sum(s2) * (1.f / DM) + EPS);
    GAS unsigned long long* o8 = (GAS unsigned long long*)orow + F.lane;
#pragma unroll
    for (int j = 0; j < 4; ++j) o8[64 * j] = (unsigned long long)pk2(v[j].x * rs, v[j].y * rs) | ((unsigned long long)pk2(v[j].z * rs, v[j].w * rs) << 32);
}
__device__ __forceinline__ void p0_prologue(Frame& F) {
    LAS float* scr = (LAS float*)(F.lds + RING_OFF + F.wave * 16384);
    const int gw = F.vcu * NWAVES + F.wave, NGW = F.G * NWAVES;
    constexpr int I_1 = (DM / 64) * ((NIN + 31) / 32), I_2 = (2048 / 64) * (DM / 32), I_3 = (DM / 64) * (DFF / 32), I_4 = (DFF / 64) * (DM / 32);
    constexpr int NITEMS = I_1 + I_2 + 2 * I_3 + I_4;
    for (int it = gw; it < NITEMS; it += NGW) {
        int r = it;
        if (r < I_1) { p0_transpose_item(F.w_in, DM, NIN, F.W1t, 1, F.n_mix_pre, F.n_mix_pre, DM, scr, r, F.lane); continue; } r -= I_1;
        if (r < I_2) { p0_transpose_item(F.w_out, 2048, DM, F.W2t, 0, F.ssm_norm, F.ret_norm, DSSM, scr, r, F.lane); continue; } r -= I_2;
        if (r < I_3) { p0_transpose_item(F.w_gate, DM, DFF, F.W3t, 2, F.n_ffn_pre, F.n_ffn_pre, DM, scr, r, F.lane); continue; } r -= I_3;
        if (r < I_3) { p0_transpose_item(F.w_up, DM, DFF, F.W3t, 3, F.n_ffn_pre, F.n_ffn_pre, DM, scr, r, F.lane); continue; } r -= I_3;
        p0_transpose_item(F.w_down, DFF, DM, F.W4t, 0, nullptr, nullptr, 0, scr, r, F.lane);
    }
    { GAS v4u* z = (GAS v4u*)(F.W1t + (size_t)(DT0 + 16) * DM); const int n16 = (LP - DT0 - 16) * DM * 2 / 16;
      for (int i = gw * 64 + F.lane; i < n16; i += NGW * 64) z[i] = (v4u){0u, 0u, 0u, 0u}; }
    for (int m = gw; m < RT; m += NGW) rms_row_to_bf16(F, x_row(F, m), F.HB + (size_t)m * DM);
}

typedef float f32x4v __attribute__((ext_vector_type(4)));
__device__ __forceinline__ float bf2f(unsigned short b) { return __builtin_bit_cast(float, (unsigned)b << 16); }
__device__ __forceinline__ float bflo(unsigned w) { return __builtin_bit_cast(float, w << 16); }
__device__ __forceinline__ float bfhi(unsigned w) { return __builtin_bit_cast(float, w & 0xffff0000u); }
__device__ __forceinline__ float silu(float x) { return x / (1.0f + __expf(-x)); }
__device__ __forceinline__ void bar_sync() { __syncthreads(); }
__device__ __forceinline__ f32x4 mma_tile(const LAS bf16* A, int pa, const LAS bf16* B, int pb, int K, f32x4 acc, int lane) {
    const int r = lane & 15, q = lane >> 4;
    const LAS bf16* ap = A + r * pa + 8 * q; const LAS bf16* bp = B + r * pb + 8 * q;
    for (int k0 = 0; k0 < K; k0 += 32) {
        const bf16x8 a = *(const LAS bf16x8*)(ap + k0), b = *(const LAS bf16x8*)(bp + k0);
        acc = __builtin_amdgcn_mfma_f32_16x16x32_bf16(a, b, acc, 0, 0, 0);
    }
    return acc;
}
__device__ const double ROT_REV[64] = {
0.15915494309189535, 0.13782250260398285, 0.11934937021124886, 0.10335229661843406,
0.08949940160889101, 0.07750328875537406, 0.06711508300522726, 0.058119267441876246,
0.050329212104487035, 0.04358330210530733, 0.03774158471741977, 0.032682865872357,
0.0283021958306234, 0.024508691862069852, 0.02122365276477766, 0.018378926105679667,
0.015915494309189534, 0.013782250260398284, 0.011934937021124886, 0.010335229661843406,
0.008949940160889102, 0.0077503288755374055, 0.006711508300522725, 0.005811926744187624,
0.005032921210448704, 0.004358330210530733, 0.003774158471741977, 0.0032682865872356993,
0.00283021958306234, 0.002450869186206985, 0.0021223652764777662, 0.0018378926105679667,
0.0015915494309189536, 0.0013782250260398288, 0.0011934937021124885, 0.0010335229661843405,
0.0008949940160889102, 0.0007750328875537405, 0.0006711508300522726, 0.0005811926744187624,
0.0005032921210448703, 0.0004358330210530733, 0.00037741584717419774, 0.0003268286587235699,
0.00028302195830623395, 0.00024508691862069854, 0.0002122365276477766, 0.00018378926105679666,
0.00015915494309189535, 0.00013782250260398286, 0.00011934937021124886, 0.00010335229661843406,
8.949940160889102e-05, 7.750328875537406e-05, 6.711508300522725e-05, 5.811926744187624e-05,
5.0329212104487035e-05, 4.358330210530732e-05, 3.774158471741978e-05, 3.2682865872357e-05,
2.8302195830623396e-05, 2.4508691862069852e-05, 2.122365276477766e-05, 1.8378926105679668e-05
};
struct SeqInfo { int r0; int tseq0; int pos0; int sb; };

__device__ __forceinline__ void raw_pair(const Frame& F, const SeqInfo& si, int t, int c, float& v0, float& v1) {
    const int ts = si.tseq0 + t;
    if (ts >= 0) { const unsigned w = *(const GAS unsigned*)(F.PROJ + (size_t)(si.r0 + t) * LP + XBC0 + c); v0 = bflo(w); v1 = bfhi(w); }
    else if (si.sb >= 0) { const float* p = F.st_conv + ((size_t)si.sb * 3 + (3 + ts)) * CONVD + c; v0 = p[0]; v1 = p[1]; }
    else { v0 = 0.f; v1 = 0.f; }
}
__device__ __forceinline__ void conv_pair(const Frame& F, const SeqInfo& si, int t, int c, float& o0, float& o1) {
    float a0 = F.conv_b[c], a1 = F.conv_b[c + 1];
#pragma unroll
    for (int k = 0; k < 4; ++k) { float v0, v1; raw_pair(F, si, t - 3 + k, c, v0, v1); a0 += v0 * F.conv_w[k * CONVD + c]; a1 += v1 * F.conv_w[k * CONVD + c + 1]; }
    o0 = silu(a0); o1 = silu(a1);
}
__device__ __forceinline__ float softplus_f(float x) { return fmaxf(x, 0.f) + log1pf(__expf(-fabsf(x))); }

constexpr int SP_A = 136, SP_T = 72;
constexpr int SS_CM = 0, SS_BM = SS_CM + 64 * SP_A * 2, SS_BT = SS_BM + 64 * SP_A * 2, SS_XT = SS_BT + 128 * SP_T * 2, SS_XW = SS_XT + 64 * SP_T * 2, SS_MM = SS_XW + 64 * SP_T * 2,
              SS_HB = SS_MM + 64 * SP_T * 2, SS_YT = SS_HB + 64 * SP_A * 2, SS_VEC = SS_YT + 64 * 65 * 4, SS_END = SS_VEC + 6 * 256 * 4;
static_assert(SS_END <= RING_BYTES, "ssd LDS map");

template <int T, int NCH, int MODE>
__device__ __forceinline__ void ssd_unit(Frame& F, const SeqInfo si, const int e, const int sidx) {
    LAS unsigned char* L = F.lds + RING_OFF;
    LAS bf16* Cm = (LAS bf16*)(L + SS_CM); LAS bf16* Bm = (LAS bf16*)(L + SS_BM); LAS bf16* Bt = (LAS bf16*)(L + SS_BT); LAS bf16* Xt = (LAS bf16*)(L + SS_XT);
    LAS bf16* Xw = (LAS bf16*)(L + SS_XW); LAS bf16* Mm = (LAS bf16*)(L + SS_MM); LAS bf16* Hb = (LAS bf16*)(L + SS_HB); LAS float* Yt = (LAS float*)(L + SS_YT);
    LAS float* dtv = (LAS float*)(L + SS_VEC); LAS float* acum = dtv + 256; LAS float* ea = acum + 256; LAS float* wv = ea + 256; LAS float* rowsq = wv + 256; LAS float* wtot = rowsq + 256;
    const int tid = F.tid, lane = F.lane, w = F.wave, r = lane & 15, q = lane >> 4;
    const int g = e >> 3;
    const float a_e = -__expf(F.a_log[e]), dtb = F.dt_bias[e], dsk = F.d_skip[e];
    constexpr int NROW = T * NCH, NT = T / 16;
    float dtl = 0.f, da = 0.f;
    if (tid < NROW) { const float raw = bf2f(*(const GAS bf16*)(F.PROJ + (size_t)(si.r0 + tid) * LP + DT0 + e)); dtl = softplus_f(raw + dtb); da = dtl * a_e; }
    float sc = da;
#pragma unroll
    for (int o = 1; o < 64; o <<= 1) { const float v = __shfl_up(sc, o); if (lane >= o) sc += v; }
    if (T == 32) {
    }
    if (tid < NROW) { dtv[tid] = dtl; acum[tid] = sc; }
    if (lane == 63) wtot[w] = sc;
    bar_sync();
    if (tid < NROW) {
        if (MODE == 0) { float off = 0.f, tot = 0.f;
#pragma unroll
            for (int i = 0; i < NROW / 64; ++i) { const float x = wtot[i]; tot += x; if (i < w) off += x; }
            wv[tid] = __expf(tot - (sc + off)) * dtl;
            if (tid == 0) F.misc[MS_DEC + (size_t)sidx * 16 + e] = __expf(tot);
        } else { const float last = acum[tid | (T - 1)]; ea[tid] = __expf(sc); wv[tid] = __expf(last - sc) * dtl; }
    }
    f32x4 hst[4];
#pragma unroll
    for (int pt = 0; pt < 4; ++pt) {
        if (MODE == 0) hst[pt] = (f32x4){0.f, 0.f, 0.f, 0.f};
        else if (MODE == 1) { const float* S = F.out + ST_SSD + ((size_t)(sidx * 16 + e) * 128) * 64;
#pragma unroll
            for (int j = 0; j < 4; ++j) hst[pt][j] = S[(size_t)(16 * w + 4 * q + j) * 64 + 16 * pt + r]; }
        else { const float* S = F.st_ssm + (size_t)(sidx * 16 + e) * 8192;
#pragma unroll
            for (int j = 0; j < 4; ++j) hst[pt][j] = S[(size_t)(16 * pt + r) * 128 + 16 * w + 4 * q + j]; }
        if (MODE != 0) { unsigned long long pk = (unsigned long long)pk2(hst[pt][0], hst[pt][1]) | ((unsigned long long)pk2(hst[pt][2], hst[pt][3]) << 32);
            *(LAS unsigned long long*)(Hb + (16 * pt + r) * SP_A + 16 * w + 4 * q) = pk; }
    }
    bar_sync();
    for (int c = 0; c < NCH; ++c) {
        const int tb = c * T;
        for (int idx = tid; idx < T * 32; idx += NTHR) { const int t = idx >> 5, c2 = (idx & 31) * 2; float o0, o1; conv_pair(F, si, tb + t, 64 * e + c2, o0, o1);
            const float ww = wv[tb + t];
            if (MODE != 0) { Xt[c2 * SP_T + t] = (bf16)f2bf(o0); Xt[(c2 + 1) * SP_T + t] = (bf16)f2bf(o1); }
            Xw[c2 * SP_T + t] = (bf16)f2bf(o0 * ww); Xw[(c2 + 1) * SP_T + t] = (bf16)f2bf(o1 * ww); }
        for (int idx = tid; idx < T * 64; idx += NTHR) { const int t = idx >> 6, n = (idx & 63) * 2; float o0, o1; conv_pair(F, si, tb + t, 1024 + 128 * g + n, o0, o1);
            if (MODE != 0) *(LAS unsigned*)(Bm + t * SP_A + n) = pk2(o0, o1);
            Bt[n * SP_T + t] = (bf16)f2bf(o0); Bt[(n + 1) * SP_T + t] = (bf16)f2bf(o1); }
        if (MODE != 0) for (int idx = tid; idx < T * 64; idx += NTHR) { const int t = idx >> 6, n = (idx & 63) * 2; float o0, o1; conv_pair(F, si, tb + t, 1280 + 128 * g + n, o0, o1);
            *(LAS unsigned*)(Cm + t * SP_A + n) = pk2(o0, o1); }
        bar_sync();
        if (MODE != 0) {
            for (int ti = w; ti < NT * NT; ti += NWAVES) { const int lt = ti / NT, st = ti % NT;
                f32x4 acc = mma_tile(Cm + 16 * lt * SP_A, SP_A, Bm + 16 * st * SP_A, SP_A, 128, (f32x4){0.f, 0.f, 0.f, 0.f}, lane);
                const int s = 16 * st + r; const float as = acum[tb + s], ds = dtv[tb + s];
#pragma unroll
                for (int j = 0; j < 4; ++j) { const int l = 16 * lt + 4 * q + j; const float m = (l >= s) ? acc[j] * __expf(acum[tb + l] - as) * ds : 0.f; Mm[l * SP_T + s] = (bf16)f2bf(m); } }
            bar_sync();
            for (int ti = w; ti < NT * 4; ti += NWAVES) { const int lt = ti >> 2, pt = ti & 3;
                f32x4 acc = mma_tile(Cm + 16 * lt * SP_A, SP_A, Hb + 16 * pt * SP_A, SP_A, 128, (f32x4){0.f, 0.f, 0.f, 0.f}, lane);
#pragma unroll
                for (int j = 0; j < 4; ++j) acc[j] *= ea[tb + 16 * lt + 4 * q + j];
                acc = mma_tile(Mm + 16 * lt * SP_T, SP_T, Xt + 16 * pt * SP_T, SP_T, T, acc, lane);
#pragma unroll
                for (int j = 0; j < 4; ++j) { const int l = 16 * lt + 4 * q + j; Yt[l * 65 + 16 * pt + r] = acc[j] + dsk * bf2f(Xt[(16 * pt + r) * SP_T + l]); } }
            bar_sync();
            for (int idx = tid; idx < T * 32; idx += NTHR) { const int l = idx >> 5, pp = idx & 31;
                GAS unsigned* zp = (GAS unsigned*)(F.PROJ + (size_t)(si.r0 + tb + l) * LP + Z0 + 64 * e + 2 * pp); const unsigned zw = *zp;
                const float y0 = Yt[l * 65 + 2 * pp] * silu(bflo(zw)), y1 = Yt[l * 65 + 2 * pp + 1] * silu(bfhi(zw));
                float ss = y0 * y0 + y1 * y1;
#pragma unroll
                for (int o = 1; o < 32; o <<= 1) ss += __shfl_xor(ss, o);
                if ((lane & 31) == 0) rowsq[tb + l] = ss;
                *zp = pk2(y0, y1); }
        }
        const float dch = (MODE == 0) ? 1.f : __expf(acum[tb + T - 1]);
#pragma unroll
        for (int pt = 0; pt < 4; ++pt) { hst[pt] = hst[pt] * dch; hst[pt] = mma_tile(Bt + 16 * w * SP_T, SP_T, Xw + 16 * pt * SP_T, SP_T, T, hst[pt], lane);
            if (MODE != 0) { unsigned long long pk = (unsigned long long)pk2(hst[pt][0], hst[pt][1]) | ((unsigned long long)pk2(hst[pt][2], hst[pt][3]) << 32);
                *(LAS unsigned long long*)(Hb + (16 * pt + r) * SP_A + 16 * w + 4 * q) = pk; } }
        bar_sync();
    }
    if (MODE == 0) { float* S = F.out + ST_SSD + ((size_t)(sidx * 16 + e) * 128) * 64;
#pragma unroll
        for (int pt = 0; pt < 4; ++pt)
#pragma unroll
            for (int j = 0; j < 4; ++j) S[(size_t)(16 * w + 4 * q + j) * 64 + 16 * pt + r] = hst[pt][j]; }
    if (MODE != 0) { if (tid < NROW) F.misc[MS_SSQ + (size_t)(si.r0 + tid) * 16 + e] = rowsq[tid]; }
    if (MODE == 2) { float* S = F.out + O_SS + (size_t)(sidx * 16 + e) * 8192;
#pragma unroll
        for (int pt = 0; pt < 4; ++pt)
#pragma unroll
            for (int j = 0; j < 4; ++j) S[(size_t)(16 * pt + r) * 128 + 16 * w + 4 * q + j] = hst[pt][j]; }
    bar_sync();
}

constexpr int RS_QM = 0, RS_KM = RS_QM + 64 * SP_A * 2, RS_KW = RS_KM + 64 * SP_A * 2, RS_VT = RS_KW + 128 * SP_T * 2, RS_PM = RS_VT + 128 * SP_T * 2, RS_ST = RS_PM + 64 * SP_T * 2,
              RS_VEC = RS_ST + 128 * SP_A * 2, RS_END = RS_VEC + 2 * 64 * 4 * 4;
static_assert(RS_END <= RING_BYTES, "retention LDS map");
template <int T, int NCH, int MODE>
__device__ __forceinline__ void ret_unit(Frame& F, const SeqInfo si, const int hh, const int sidx) {
    LAS unsigned char* L = F.lds + RING_OFF;
    LAS bf16* Qm = (LAS bf16*)(L + RS_QM); LAS bf16* Km = (LAS bf16*)(L + RS_KM); LAS bf16* Yb = Km; LAS bf16* Kw = (LAS bf16*)(L + RS_KW); LAS bf16* Vt = (LAS bf16*)(L + RS_VT);
    LAS bf16* Pm = (LAS bf16*)(L + RS_PM); LAS bf16* St = (LAS bf16*)(L + RS_ST); LAS float* part = (LAS float*)(L + RS_VEC); LAS float* part2 = part + 256;
    const int tid = F.tid, lane = F.lane, w = F.wave, r = lane & 15, q = lane >> 4;
    constexpr int NROW = T * NCH, NT = T / 16, NSH = 8 / NT;
    const float lg2 = log2f(1.0f - exp2f(-5.0f - (float)hh));
    f32x4 sst[8];
#pragma unroll
    for (int i = 0; i < 8; ++i) {
        if (MODE == 0) sst[i] = (f32x4){0.f, 0.f, 0.f, 0.f};
        else { const float* S = (MODE == 1) ? F.out + ST_RET + (size_t)(sidx * 8 + hh) * 16384 : F.st_ret + (size_t)(sidx * 8 + hh) * 16384;
#pragma unroll
            for (int j = 0; j < 4; ++j) sst[i][j] = S[(size_t)(16 * w + 4 * q + j) * 128 + 16 * i + r];
            unsigned long long pk = (unsigned long long)pk2(sst[i][0], sst[i][1]) | ((unsigned long long)pk2(sst[i][2], sst[i][3]) << 32);
            *(LAS unsigned long long*)(St + (16 * i + r) * SP_A + 16 * w + 4 * q) = pk; }
    }
    for (int c = 0; c < NCH; ++c) {
        const int tb = c * T;
        for (int idx = tid; idx < T * 64; idx += NTHR) { const int t = idx >> 6, j = idx & 63;
            const double rev = (double)(si.pos0 + tb + t) * ROT_REV[j]; const float fr = (float)(rev - __builtin_floor(rev));
            const float cs = __builtin_amdgcn_cosf(fr), sn = __builtin_amdgcn_sinf(fr);
            const GAS bf16* row = (const GAS bf16*)(F.PROJ + (size_t)(si.r0 + tb + t) * LP);
            const float k1 = bf2f(row[K0 + 128 * hh + j]), k2 = bf2f(row[K0 + 128 * hh + 64 + j]);
            const float kk1 = (k1 * cs - k2 * sn) * 0.08838834764831845f, kk2 = (k1 * sn + k2 * cs) * 0.08838834764831845f;
            const float kwt = exp2f(lg2 * (float)((MODE == 0 ? NROW - 1 - tb : T - 1) - t));
            Kw[j * SP_T + t] = (bf16)f2bf(kk1 * kwt); Kw[(j + 64) * SP_T + t] = (bf16)f2bf(kk2 * kwt);
            if (MODE != 0) { const float q1 = bf2f(row[Q0 + 128 * hh + j]), q2 = bf2f(row[Q0 + 128 * hh + 64 + j]);
                Qm[t * SP_A + j] = (bf16)f2bf(q1 * cs - q2 * sn); Qm[t * SP_A + 64 + j] = (bf16)f2bf(q1 * sn + q2 * cs);
                Km[t * SP_A + j] = (bf16)f2bf(kk1); Km[t * SP_A + 64 + j] = (bf16)f2bf(kk2); } }
        for (int idx = tid; idx < T * 64; idx += NTHR) { const int t = idx >> 6, e2 = (idx & 63) * 2;
            const unsigned vw = *(const GAS unsigned*)(F.PROJ + (size_t)(si.r0 + tb + t) * LP + V0 + 128 * hh + e2);
            Vt[e2 * SP_T + t] = (bf16)(vw & 0xffffu); Vt[(e2 + 1) * SP_T + t] = (bf16)(vw >> 16); }
        bar_sync();
        if (MODE != 0) {
            for (int ti = w; ti < NT * NT; ti += NWAVES) { const int lt = ti / NT, st = ti % NT;
                f32x4 acc = mma_tile(Qm + 16 * lt * SP_A, SP_A, Km + 16 * st * SP_A, SP_A, 128, (f32x4){0.f, 0.f, 0.f, 0.f}, lane);
                const int s = 16 * st + r;
#pragma unroll
                for (int j = 0; j < 4; ++j) { const int l = 16 * lt + 4 * q + j; const float m = (l >= s) ? acc[j] * exp2f(lg2 * (float)(l - s)) : 0.f; Pm[l * SP_T + s] = (bf16)f2bf(m); } }
            bar_sync();
            const int lt = w % NT, slot = w / NT;
            f32x4 acc[NT];
#pragma unroll
            for (int i = 0; i < NT; ++i) { const int et = slot * NT + i;
                acc[i] = mma_tile(Qm + 16 * lt * SP_A, SP_A, St + 16 * et * SP_A, SP_A, 128, (f32x4){0.f, 0.f, 0.f, 0.f}, lane);
#pragma unroll
                for (int j = 0; j < 4; ++j) acc[i][j] *= exp2f(lg2 * (float)(16 * lt + 4 * q + j + 1));
                acc[i] = mma_tile(Pm + 16 * lt * SP_T, SP_T, Vt + 16 * et * SP_T, SP_T, T, acc[i], lane); }
            float mean[4], rstd[4];
#pragma unroll
            for (int j = 0; j < 4; ++j) { float s = 0.f;
#pragma unroll
                for (int i = 0; i < NT; ++i) s += acc[i][j];
                s += __shfl_xor(s, 1); s += __shfl_xor(s, 2); s += __shfl_xor(s, 4); s += __shfl_xor(s, 8);
                if (r == 0) part[(16 * lt + 4 * q + j) * 4 + slot] = s; }
            bar_sync();
#pragma unroll
            for (int j = 0; j < 4; ++j) { float s = 0.f;
#pragma unroll
                for (int k = 0; k < NSH; ++k) s += part[(16 * lt + 4 * q + j) * 4 + k];
                mean[j] = s * (1.0f / 128.0f); float d2 = 0.f;
#pragma unroll
                for (int i = 0; i < NT; ++i) { const float d = acc[i][j] - mean[j]; d2 += d * d; }
                d2 += __shfl_xor(d2, 1); d2 += __shfl_xor(d2, 2); d2 += __shfl_xor(d2, 4); d2 += __shfl_xor(d2, 8);
                if (r == 0) part2[(16 * lt + 4 * q + j) * 4 + slot] = d2; }
            bar_sync();
#pragma unroll
            for (int j = 0; j < 4; ++j) { float s = 0.f;
#pragma unroll
                for (int k = 0; k < NSH; ++k) s += part2[(16 * lt + 4 * q + j) * 4 + k];
                rstd[j] = 1.0f / sqrtf(s * (1.0f / 128.0f) + EPS); }
#pragma unroll
            for (int i = 0; i < NT; ++i)
#pragma unroll
                for (int j = 0; j < 4; ++j) Yb[(16 * lt + 4 * q + j) * SP_A + 16 * (slot * NT + i) + r] = (bf16)f2bf((acc[i][j] - mean[j]) * rstd[j]);
            bar_sync();
            for (int idx = tid; idx < T * 16; idx += NTHR) { const int l = idx >> 4, ch = idx & 15;
                const v4u yv = *(const LAS v4u*)(Yb + l * SP_A + 8 * ch);
                GAS v4u* gp = (GAS v4u*)(F.PROJ + (size_t)(si.r0 + tb + l) * LP + G0 + 128 * hh + 8 * ch); const v4u gv = *gp;
                v4u o;
#pragma unroll
                for (int k = 0; k < 4; ++k) o[k] = pk2(bflo(yv[k]) * silu(bflo(gv[k])), bfhi(yv[k]) * silu(bfhi(gv[k])));
                *gp = o; }
        }
        const float dch = (MODE == 0) ? 1.f : exp2f(lg2 * (float)T);
#pragma unroll
        for (int i = 0; i < 8; ++i) { sst[i] = sst[i] * dch; sst[i] = mma_tile(Kw + 16 * w * SP_T, SP_T, Vt + 16 * i * SP_T, SP_T, T, sst[i], lane);
            if (MODE != 0) { unsigned long long pk = (unsigned long long)pk2(sst[i][0], sst[i][1]) | ((unsigned long long)pk2(sst[i][2], sst[i][3]) << 32);
                *(LAS unsigned long long*)(St + (16 * i + r) * SP_A + 16 * w + 4 * q) = pk; } }
        bar_sync();
    }
    if (MODE == 0 || MODE == 2) { float* S = (MODE == 0) ? F.out + ST_RET + (size_t)(sidx * 8 + hh) * 16384 : F.out + O_RS + (size_t)(sidx * 8 + hh) * 16384;
#pragma unroll
        for (int i = 0; i < 8; ++i)
#pragma unroll
            for (int j = 0; j < 4; ++j) S[(size_t)(16 * w + 4 * q + j) * 128 + 16 * i + r] = sst[i][j]; }
    bar_sync();
}

__device__ __forceinline__ SeqInfo prompt_panel(int gp) { SeqInfo s; s.r0 = gp * 256; s.tseq0 = (gp & 63) * 256; s.pos0 = s.tseq0; s.sb = -1; return s; }
__device__ __forceinline__ SeqInfo sample_seq(int sb) { SeqInfo s; s.r0 = RP + sb * SL; s.tseq0 = 0; s.pos0 = PASTLEN; s.sb = sb; return s; }
constexpr int NU_RET_P = NPP * RH, NU_SSD_P = NPP * NH, NU_RET_S = SBN * RH, NU_SSD_S = SBN * NH;
__device__ __forceinline__ void phase_local_states(Frame& F) {
    for (int u = F.vcu; u < NU_RET_P + NU_SSD_P; u += F.G) {
        if (u < NU_RET_P) ret_unit<64, 4, 0>(F, prompt_panel(u >> 3), u & 7, u >> 3);
        else { const int v = u - NU_RET_P; ssd_unit<64, 4, 0>(F, prompt_panel(v >> 4), v & 15, v >> 4); }
    }
}
__device__ __forceinline__ void phase_state_pass(Frame& F) {
    const int gt = F.vcu * NTHR + F.tid, NGT = F.G * NTHR;
    constexpr int NCHAIN = PB * NH * 8192;
    for (int ch = gt; ch < 2 * NCHAIN; ch += NGT) {
        if (ch < NCHAIN) { const int b = ch / (NH * 8192), rem = ch % (NH * 8192), e = rem >> 13, idx = rem & 8191;
            float* S = F.out + ST_SSD + ((size_t)(b * 64) * 16 + e) * 8192 + idx; const float* D = F.misc + MS_DEC + (size_t)(b * 64) * 16 + e;
            float h = 0.f;
#pragma unroll 8
            for (int p = 0; p < 64; ++p) { const float s = S[(size_t)p * 16 * 8192]; const float d = __hip_atomic_load(D + p * 16, __ATOMIC_RELAXED, __HIP_MEMORY_SCOPE_AGENT); S[(size_t)p * 16 * 8192] = h; h = d * h + s; }
            F.out[O_SP + ((size_t)(b * 16 + e) * 64 + (idx & 63)) * 128 + (idx >> 6)] = h;
        } else { const int c2 = ch - NCHAIN; const int b = c2 / (RH * 16384), rem = c2 % (RH * 16384), hh = rem >> 14, idx = rem & 16383;
            float* S = F.out + ST_RET + ((size_t)(b * 64) * 8 + hh) * 16384 + idx; const float d = exp2f(256.0f * log2f(1.0f - exp2f(-5.0f - (float)hh)));
            float h = 0.f;
#pragma unroll 8
            for (int p = 0; p < 64; ++p) { const float s = S[(size_t)p * 8 * 16384]; S[(size_t)p * 8 * 16384] = h; h = d * h + s; }
            F.out[O_RP + (size_t)(b * 8 + hh) * 16384 + idx] = h;
        }
    }
    for (int i = gt; i < (PB + SBN) * 3 * CONVD; i += NGT) { const int sq = i / (3 * CONVD), rem = i % (3 * CONVD), j = rem / CONVD, c = rem % CONVD;
        if (sq < PB) F.out[O_CP + (size_t)i] = bf2f(*(const GAS bf16*)(F.PROJ + (size_t)(sq * PL + PL - 3 + j) * LP + XBC0 + c));
        else { const int sb = sq - PB; F.out[O_CS + (size_t)(sb * 3 + j) * CONVD + c] = bf2f(*(const GAS bf16*)(F.PROJ + (size_t)(RP + sb * SL + SL - 3 + j) * LP + XBC0 + c)); } }
}
__device__ __forceinline__ void phase_outputs(Frame& F) {
    constexpr int NU = NU_RET_P + NU_SSD_P + NU_RET_S + NU_SSD_S;
    for (int u = F.vcu; u < NU; u += F.G) {
        int v = u;
        if (v < NU_RET_P) { ret_unit<64, 4, 1>(F, prompt_panel(v >> 3), v & 7, v >> 3); continue; } v -= NU_RET_P;
        if (v < NU_SSD_P) { ssd_unit<64, 4, 1>(F, prompt_panel(v >> 4), v & 15, v >> 4); continue; } v -= NU_SSD_P;
        if (v < NU_RET_S) { ret_unit<32, 1, 2>(F, sample_seq(v >> 3), v & 7, v >> 3); continue; } v -= NU_RET_S;
        ssd_unit<32, 1, 2>(F, sample_seq(v >> 4), v & 15, v >> 4);
    }
}
__device__ __forceinline__ void phase_ssm_norm(Frame& F) {
    const int gw = F.vcu * NWAVES + F.wave, NGW = F.G * NWAVES;
    for (int m = gw; m < RT; m += NGW) {
        const int grp = F.lane >> 5; float ss = 0.f;
#pragma unroll
        for (int k = 0; k < 8; ++k) ss += F.misc[MS_SSQ + (size_t)m * 16 + grp * 8 + k];
        const float rs = 1.0f / sqrtf(ss * (1.0f / 512.0f) + EPS);
        GAS v4u* p = (GAS v4u*)(F.PROJ + (size_t)m * LP + Z0 + 16 * F.lane);
#pragma unroll
        for (int h = 0; h < 2; ++h) { v4u v = p[h];
#pragma unroll
            for (int k = 0; k < 4; ++k) v[k] = pk2(bflo(v[k]) * rs, bfhi(v[k]) * rs);
            p[h] = v; }
    }
}
__device__ __forceinline__ void phase_rows_mid(Frame& F) {
    const int gw = F.vcu * NWAVES + F.wave, NGW = F.G * NWAVES;
    const float* raw = (const float*)(F.PROJ + RAW2_0);
    for (int m = gw; m < RT; m += NGW) {
        const GAS f32x4* rr = (const GAS f32x4*)(raw + (size_t)m * (LP / 2)) + F.lane; const GAS f32x4* xr = (const GAS f32x4*)x_row(F, m) + F.lane;
        f32x4 v[4]; float s2 = 0.f;
#pragma unroll
        for (int j = 0; j < 4; ++j) { v[j] = rr[64 * j]; s2 += (v[j].x * v[j].x + v[j].y * v[j].y) + (v[j].z * v[j].z + v[j].w * v[j].w); }
        const float rs = 1.0f / sqrtf(wave_sum(s2) * (1.f / DM) + EPS); float t2 = 0.f;
        GAS f32x4* o = (GAS f32x4*)(F.out + (size_t)m * DM) + F.lane;
#pragma unroll
        for (int j = 0; j < 4; ++j) { const f32x4 gg = *((const GAS f32x4*)F.n_mix_post + F.lane + 64 * j); v[j] = xr[64 * j] + v[j] * rs * gg; o[64 * j] = v[j];
            t2 += (v[j].x * v[j].x + v[j].y * v[j].y) + (v[j].z * v[j].z + v[j].w * v[j].w); }
        const float rs2 = 1.0f / sqrtf(wave_sum(t2) * (1.f / DM) + EPS);
        GAS unsigned long long* o8 = (GAS unsigned long long*)(F.PROJ + (size_t)m * LP + HF0) + F.lane;
#pragma unroll
        for (int j = 0; j < 4; ++j) o8[64 * j] = (unsigned long long)pk2(v[j].x * rs2, v[j].y * rs2) | ((unsigned long long)pk2(v[j].z * rs2, v[j].w * rs2) << 32);
    }
}
__device__ __forceinline__ void phase_rows_end(Frame& F) {
    const int gw = F.vcu * NWAVES + F.wave, NGW = F.G * NWAVES;
    const float* raw = (const float*)(F.PROJ);
    for (int m = gw; m < RT; m += NGW) {
        const GAS f32x4* rr = (const GAS f32x4*)(raw + (size_t)m * (LP / 2)) + F.lane; GAS f32x4* o = (GAS f32x4*)(F.out + (size_t)m * DM) + F.lane;
        f32x4 v[4]; float s2 = 0.f;
#pragma unroll
        for (int j = 0; j < 4; ++j) { v[j] = rr[64 * j]; s2 += (v[j].x * v[j].x + v[j].y * v[j].y) + (v[j].z * v[j].z + v[j].w * v[j].w); }
        const float rs = 1.0f / sqrtf(wave_sum(s2) * (1.f / DM) + EPS);
#pragma unroll
        for (int j = 0; j < 4; ++j) { const f32x4 gg = *((const GAS f32x4*)F.n_ffn_post + F.lane + 64 * j); o[64 * j] = o[64 * j] + v[j] * rs * gg; }
    }
}

struct Args { const float* in[21]; float* out; unsigned char* ws; int ph_lo, ph_hi; };
__global__ void __launch_bounds__(NTHR, 2) hybrid_fwd(Args args) {
    extern __shared__ __attribute__((aligned(16))) unsigned char lds[];
    Frame F;
    F.lds = (LAS unsigned char*)lds;
    F.MISC = (volatile LAS unsigned*)(F.lds + MISC_OFF);
    F.tid = threadIdx.x; F.lane = F.tid & 63; F.wave = __builtin_amdgcn_readfirstlane(F.tid >> 6);
    F.G = gridDim.x; { const int bx = blockIdx.x; F.vcu = (F.G % 8 == 0) ? (bx % 8) * (F.G / 8) + bx / 8 : bx; }
    unsigned char* ws = args.ws;
    F.ctl = (gu32*)(ws + WS_CTL);
    F.xp = args.in[0]; F.xs = args.in[1]; F.st_conv = args.in[2]; F.st_ssm = args.in[3]; F.st_ret = args.in[4]; F.n_mix_pre = args.in[5]; F.n_mix_post = args.in[6];
    F.n_ffn_pre = args.in[7]; F.n_ffn_post = args.in[8]; F.w_in = args.in[9]; F.conv_w = args.in[10]; F.conv_b = args.in[11]; F.dt_bias = args.in[12]; F.a_log = args.in[13];
    F.d_skip = args.in[14]; F.ssm_norm = args.in[15]; F.ret_norm = args.in[16]; F.w_out = args.in[17]; F.w_gate = args.in[18]; F.w_up = args.in[19]; F.w_down = args.in[20];
    F.out = args.out;
    F.W1t = (bf16*)(ws + WS_W1); F.W2t = (bf16*)(ws + WS_W2); F.W3t = (bf16*)(ws + WS_W3); F.W4t = (bf16*)(ws + WS_W4); F.PROJ = (bf16*)(ws + WS_PROJ);
    F.HB = (bf16*)args.out;
    F.misc = (float*)(ws + WS_MISC);
    for (int u = F.tid; u < (LDS_BYTES - LDSCTL_OFF) / 4; u += NTHR) ((LAS unsigned*)(F.lds + LDSCTL_OFF))[u] = 0u;
    __syncthreads();
    XcdBarrier bar = xcd_barrier_post((unsigned*)(F.ctl + CW_BAR), F.MISC + 8);
#define GRID_BAR() xcd_barrier(bar)
    const int lo = args.ph_lo, hi = args.ph_hi;
#define IN(k) (lo <= (k) && (k) < hi)
    if (IN(0)) { p0_prologue(F); GRID_BAR(); }
    if (IN(1)) { pg8::Gemm g{F.HB, F.W1t, RT, LP, DM, DM}; pg8::StaticOrder S; S.init(RT, LP, F.G, (int)blockIdx.x);
        pg8::EpiBf16 E{F.PROJ, LP};
        pg8::gemm_phase<pg8::EpiBf16, pg8::StaticOrder, true, true>(F.lds + RING_OFF, g, S, E); GRID_BAR(); }
    if (IN(2)) { phase_local_states(F); GRID_BAR(); }
    if (IN(3)) { phase_state_pass(F); GRID_BAR(); }
    if (IN(4)) { phase_outputs(F); GRID_BAR(); }
    if (IN(5)) { phase_ssm_norm(F); GRID_BAR(); }
    if (IN(6)) { pg8::Gemm g{F.PROJ + Z0, F.W2t, RT, DM, 2048, LP}; pg8::StaticOrder S; S.init(RT, DM, F.G, (int)blockIdx.x);
        pg8::EpiF32 E{(float*)(F.PROJ + RAW2_0), LP / 2};
        pg8::gemm_phase<pg8::EpiF32, pg8::StaticOrder, true, true>(F.lds + RING_OFF, g, S, E); GRID_BAR(); }
    if (IN(7)) { phase_rows_mid(F); GRID_BAR(); }
    if (IN(8)) { pg8::Gemm g{F.PROJ + HF0, F.W3t, RT, 2 * DFF, DM, LP}; pg8::StaticOrder S; S.init(RT, 2 * DFF, F.G, (int)blockIdx.x);
        pg8::EpiSwiGLU E{F.PROJ + ACT0, LP};
        pg8::gemm_phase<pg8::EpiSwiGLU, pg8::StaticOrder, true, true>(F.lds + RING_OFF, g, S, E); GRID_BAR(); }
    if (IN(9)) { pg8::Gemm g{F.PROJ + ACT0, F.W4t, RT, DM, DFF, LP}; pg8::StaticOrder S; S.init(RT, DM, F.G, (int)blockIdx.x);
        pg8::EpiF32 E{(float*)(F.PROJ), LP / 2};
        pg8::gemm_phase<pg8::EpiF32, pg8::StaticOrder, true, true>(F.lds + RING_OFF, g, S, E); GRID_BAR(); }
    if (IN(10)) { phase_rows_end(F); }
#undef IN
}

extern "C" void kernel_launch(void* const* d_in, const int* in_sizes, int n_in, void* d_out, int out_size, void* d_ws, size_t ws_size, hipStream_t stream) {
    static int grid = 0;
    if (grid == 0) {
        if (n_in != 21 || out_size != (int)O_END || ws_size < WS_END) { fprintf(stderr, "kernel_launch: unexpected sizes n_in %d out %d ws %zu (need %zu)\n", n_in, out_size, ws_size, (size_t)WS_END); grid = -1; return; }
        int dev = 0, cus = 0;
        if (hipGetDevice(&dev) != hipSuccess || hipDeviceGetAttribute(&cus, hipDeviceAttributeMultiprocessorCount, dev) != hipSuccess) { grid = -1; return; }
        if (hipFuncSetAttribute((const void*)hybrid_fwd, hipFuncAttributeMaxDynamicSharedMemorySize, LDS_BYTES) != hipSuccess) { grid = -1; return; }
        int per_cu = 0;
        if (hipOccupancyMaxActiveBlocksPerMultiprocessor(&per_cu, (const void*)hybrid_fwd, NTHR, LDS_BYTES) != hipSuccess || per_cu < 1) fprintf(stderr, "kernel_launch: occupancy query says %d\n", per_cu);
        (void)hipGetLastError();
        grid = cus;
    }
    if (grid < 0) return;
    if (hipMemsetAsync((char*)d_ws + WS_CTL, 0, CTL_ZERO_BYTES, stream) != hipSuccess) return;
    Args a{};
    for (int i = 0; i < 21; ++i) a.in[i] = (const float*)d_in[i];
    a.out = (float*)d_out; a.ws = (unsigned char*)d_ws; a.ph_lo = 0; a.ph_hi = 11;
    hipLaunchKernelGGL(hybrid_fwd, dim3(grid), dim3(NTHR), LDS_BYTES, stream, a);
}
```

```cpp
#include <hip/hip_runtime.h>
#include <cstdio>
#include <cstdint>
#define PROBE 0
#define PROBE_LDS_WORD(k) ((volatile __attribute__((address_space(3))) unsigned*)(lds + (163840 - 512 + 320)) + 16 + (k))
__device__ __forceinline__ int hw_lane() { unsigned z = 0u; asm volatile("" : "+v"(z)); return (int)__builtin_amdgcn_mbcnt_hi(~0u, __builtin_amdgcn_mbcnt_lo(~0u, z)); }
__device__ __forceinline__ int shfl_idx_i(int v, int src) { return __builtin_amdgcn_ds_bpermute(src << 2, v); }
__device__ __forceinline__ int   my_shfl_xor(int v, int m)   { return shfl_idx_i(v, hw_lane() ^ m); }
__device__ __forceinline__ unsigned my_shfl_xor(unsigned v, int m) { return (unsigned)shfl_idx_i((int)v, hw_lane() ^ m); }
__device__ __forceinline__ float my_shfl_xor(float v, int m) { return __builtin_bit_cast(float, shfl_idx_i(__builtin_bit_cast(int, v), hw_lane() ^ m)); }
__device__ __forceinline__ int   my_shfl(int v, int src)     { return shfl_idx_i(v, src & 63); }
__device__ __forceinline__ unsigned my_shfl(unsigned v, int src) { return (unsigned)shfl_idx_i((int)v, src & 63); }
__device__ __forceinline__ float my_shfl(float v, int src)   { return __builtin_bit_cast(float, shfl_idx_i(__builtin_bit_cast(int, v), src & 63)); }
__device__ __forceinline__ int   my_shfl_up(int v, int d)    { const int l = hw_lane(); return shfl_idx_i(v, l - d < 0 ? l : l - d); }
__device__ __forceinline__ unsigned my_shfl_up(unsigned v, int d) { const int l = hw_lane(); return (unsigned)shfl_idx_i((int)v, l - d < 0 ? l : l - d); }
__device__ __forceinline__ float my_shfl_up(float v, int d)  { const int l = hw_lane(); return __builtin_bit_cast(float, shfl_idx_i(__builtin_bit_cast(int, v), l - d < 0 ? l : l - d)); }
#define __shfl_xor my_shfl_xor
#define __shfl_up my_shfl_up
#define __shfl my_shfl
namespace pg8 {
#define PG8_LAS __attribute__((address_space(3)))
typedef unsigned short bf16_t;
typedef short bf16x8 __attribute__((ext_vector_type(8)));
typedef float f32x4 __attribute__((ext_vector_type(4)));
typedef unsigned u32x4 __attribute__((ext_vector_type(4)));
constexpr int BM = 256, BK = 64, HALF = 128, HTB = HALF * BK * 2  , STAGE_BYTES = 8 * HTB, NXCD = 8, WGM = 8;

__host__ __device__ __forceinline__ int lds_byte(int r, int c) { const int st = (r >> 4) * 2 + (c >> 5), rr = r & 15, cc = c & 31, ob = rr * 64 + cc * 2; return st * 1024 + (ob ^ (((ob >> 9) & 1) << 5)); }
__host__ __device__ __forceinline__ void stage_rc(int b, int& R, int& C) { const int st = b / 1024, sb = b % 1024, swz = sb ^ (((sb >> 9) & 1) << 5); R = (st >> 1) * 16 + swz / 64; C = (st & 1) * 32 + (swz % 64) / 2; }
__host__ __device__ __forceinline__ int perm32(int rho) { const int n = rho >> 4, i = rho & 15; return 8 * (i >> 2) + 4 * n + (i & 3); }

struct Unit { int pm, pn, kb; };
struct Gemm { const bf16_t* A; const bf16_t* Bt; int M, N, K, lda, ldb; };

struct StaticOrder {
    int nM, nN, nwg, G, c;
    __host__ __device__ void init(int M, int N, int G_, int c_) { nM = M / BM; nN = N / BM; nwg = nM * nN; G = G_; c = c_; }
    __host__ __device__ bool next(int i, Unit& u) const {
        const long L = (long)i * G + c; if (L >= nwg) return false;
        int wgid = (int)L; { const int q = nwg / NXCD, r = nwg % NXCD, xcd = wgid % NXCD, off = wgid / NXCD; wgid = (xcd < r ? xcd * (q + 1) : r * (q + 1) + (xcd - r) * q) + off; }
        const int nig = WGM * nN, gid = wgid / nig, fm = gid * WGM, gsz = (nM - fm) < WGM ? (nM - fm) : WGM;
        u.pm = fm + ((wgid % nig) % gsz); u.pn = (wgid % nig) / gsz; u.kb = 0; return true;
    }
    __device__ __forceinline__ void a_ready(const Unit&) const {}
    __device__ __forceinline__ void done(const Unit&) const {}
};

__device__ __forceinline__ unsigned cvt_pk_bf16(float lo, float hi) { unsigned r; asm volatile("v_cvt_pk_bf16_f32 %0, %1, %2" : "=v"(r) : "v"(lo), "v"(hi)); return r; }
__host__ __device__ __forceinline__ int tile_perm(int t) { return (t & ~255) + 128 * ((t >> 5) & 1) + 32 * ((t >> 6) & 3) + (t & 31); }
__device__ __forceinline__ void store_full_lines(bf16_t* tile_row0  , int ldc, int fr, int fq, const u32x4& p0, const u32x4& p1, bf16_t* halo_row0 = nullptr, int halo_ld = 0) {
    const bool lo = fr < 8; u32x4 send = lo ? p1 : p0, recv;
#pragma unroll
    for (int k = 0; k < 4; ++k) recv[k] = (unsigned)__shfl_xor((int)send[k], 8);
    const int colo = (lo ? 0 : 32) + 8 * fq, r8 = fr & 7;
    __builtin_nontemporal_store(lo ? p0 : recv, (u32x4*)(tile_row0 + (size_t)r8 * ldc + colo));
    const u32x4 wB = lo ? recv : p1;
    __builtin_nontemporal_store(wB, (u32x4*)(tile_row0 + (size_t)(8 + r8) * ldc + colo));
    if (halo_row0 != nullptr && r8 >= 5) *(u32x4*)(halo_row0 + (size_t)(r8 - 5) * halo_ld + colo) = wB;
}
__device__ __forceinline__ void full_lines_pair(int fr, const u32x4& p0, const u32x4& p1, u32x4& wA, u32x4& wB) {
    const bool lo = fr < 8; u32x4 send = lo ? p1 : p0, recv;
#pragma unroll
    for (int k = 0; k < 4; ++k) recv[k] = (unsigned)__shfl_xor((int)send[k], 8);
    wA = lo ? p0 : recv; wB = lo ? recv : p1;
}
struct EpiBf16 {
    static constexpr bool PERM = true, AFTER_DRAIN = false, KSCALE = false;
    bf16_t* O; int ldc;
    __device__ __forceinline__ void operator()(const f32x4 (&acc)[2][2][4][2], const Unit& u, int wr, int wc, int fr, int fq) const {
#pragma unroll
        for (int ai = 0; ai < 2; ++ai)
#pragma unroll
            for (int m = 0; m < 4; ++m) { u32x4 w[2];
#pragma unroll
                for (int bj = 0; bj < 2; ++bj) { const f32x4 v0 = acc[ai][bj][m][0], v1 = acc[ai][bj][m][1];
                    w[bj].x = cvt_pk_bf16(v0[0], v0[1]); w[bj].y = cvt_pk_bf16(v0[2], v0[3]); w[bj].z = cvt_pk_bf16(v1[0], v1[1]); w[bj].w = cvt_pk_bf16(v1[2], v1[3]); }
                store_full_lines(O + (size_t)(u.pm * BM + ai * HALF + wr * 64 + m * 16) * ldc + u.pn * BM + 64 * wc, ldc, fr, fq, w[0], w[1]); }
    }
    __device__ __forceinline__ int defer(const f32x4 (&acc)[2][2][4][2], const Unit& u, int wr, int wc, int fr, int fq, u32x4 (&dq)[8], char*& dbase, int& s1, int& s2, int& s4) const {
        asm volatile("" : "+v"(fr), "+v"(fq));
#pragma unroll
        for (int ai = 0; ai < 2; ++ai)
#pragma unroll
            for (int m = 0; m < 4; ++m) { u32x4 w[2];
#pragma unroll
                for (int bj = 0; bj < 2; ++bj) { const f32x4 v0 = acc[ai][bj][m][0], v1 = acc[ai][bj][m][1];
                    w[bj].x = cvt_pk_bf16(v0[0], v0[1]); w[bj].y = cvt_pk_bf16(v0[2], v0[3]); w[bj].z = cvt_pk_bf16(v1[0], v1[1]); w[bj].w = cvt_pk_bf16(v1[2], v1[3]); }
                if (ai == 0) store_full_lines(O + (size_t)(u.pm * BM + wr * 64 + m * 16) * ldc + u.pn * BM + 64 * wc, ldc, fr, fq, w[0], w[1]);
                else full_lines_pair(fr, w[0], w[1], dq[2 * m], dq[2 * m + 1]); }
        dbase = (char*)(O + (size_t)(u.pm * BM + HALF + wr * 64 + (fr & 7)) * ldc + u.pn * BM + 64 * wc + (fr < 8 ? 0 : 32) + 8 * fq);
        s1 = 16 * ldc; s2 = 32 * ldc; s4 = 64 * ldc; return 0;
    }
};
struct EpiBf16KS : EpiBf16 {
    static constexpr bool KSCALE = true;
    const float* grs;
    __device__ __forceinline__ void kscale(f32x4 (&acc)[2][2][4][2], const Unit& u, int wr, int fr, int seg) const {
        asm volatile("" : "+v"(fr));
#pragma unroll
        for (int ai = 0; ai < 2; ++ai)
#pragma unroll
            for (int m = 0; m < 4; ++m) { const float* p = grs + (size_t)(u.pm * BM + ai * HALF + wr * 64 + m * 16 + fr) * 2;
                const float r0 = __hip_atomic_load(p, __ATOMIC_RELAXED, __HIP_MEMORY_SCOPE_AGENT), r1 = __hip_atomic_load(p + 1, __ATOMIC_RELAXED, __HIP_MEMORY_SCOPE_AGENT);
                const float f = seg == 0 ? r0 / r1 : r1;
#pragma unroll
                for (int bj = 0; bj < 2; ++bj)
#pragma unroll
                    for (int n = 0; n < 2; ++n) acc[ai][bj][m][n] = acc[ai][bj][m][n] * f; }
    }
};
struct EpiProj {
    static constexpr bool PERM = true, AFTER_DRAIN = false, KSCALE = false;
    bf16_t* O; int ldc; const float* rot; bf16_t* halo;
    __device__ __forceinline__ void operator()(const f32x4 (&acc)[2][2][4][2], const Unit& u, int wr, int wc, int fr, int fq) const {
        const int row0 = u.pm * BM + wr * 64 + fr;
        if (u.pn >= 14 && u.pn < 22) {
            const int seg = (u.pn < 18) ? 3584 : 4608, tile = (u.pn < 18) ? u.pn - 14 : u.pn - 18;
            const int head = 2 * tile + (wc >> 1), j0 = (wc & 1) * 32 + 8 * fq;
            const float lgs = ((u.pn < 18) ? 1.f : -1.f) * log2f(1.0f - exp2f(-5.0f - (float)head));
            const int pos0 = row0 < 32768 ? (row0 & 16383) : 1024 + ((row0 - 32768) & 31);
            const float* cp = rot + (size_t)pos0 * 64 + j0; const float* sp = cp + 16384 * 64; const float* cd = rot + (size_t)16 * 64 + j0; const float* sd = cd + 16384 * 64;
            f32x4 c0 = *(const f32x4*)cp, c1 = *(const f32x4*)(cp + 4), s0 = *(const f32x4*)sp, s1 = *(const f32x4*)(sp + 4);
            const f32x4 dc0 = *(const f32x4*)cd, dc1 = *(const f32x4*)(cd + 4), ds0 = *(const f32x4*)sd, ds1 = *(const f32x4*)(sd + 4);
            auto emit = [&](int ai, int m, int row, float fac) {
                const f32x4 x1a = acc[ai][0][m][0], x1b = acc[ai][0][m][1], x2a = acc[ai][1][m][0], x2b = acc[ai][1][m][1];
                const f32x4 o1a = (x1a * c0 - x2a * s0) * fac, o1b = (x1b * c1 - x2b * s1) * fac, o2a = (x1a * s0 + x2a * c0) * fac, o2b = (x1b * s1 + x2b * c1) * fac;
                bf16_t* rowp = O + (size_t)row * ldc + seg + 128 * head + j0;
                u32x4 w; w.x = cvt_pk_bf16(o1a[0], o1a[1]); w.y = cvt_pk_bf16(o1a[2], o1a[3]); w.z = cvt_pk_bf16(o1b[0], o1b[1]); w.w = cvt_pk_bf16(o1b[2], o1b[3]);
                __builtin_nontemporal_store(w, (u32x4*)rowp);
                w.x = cvt_pk_bf16(o2a[0], o2a[1]); w.y = cvt_pk_bf16(o2a[2], o2a[3]); w.z = cvt_pk_bf16(o2b[0], o2b[1]); w.w = cvt_pk_bf16(o2b[2], o2b[3]);
                __builtin_nontemporal_store(w, (u32x4*)(rowp + 64)); };
            if (u.pm >= 128) {
#pragma unroll
                for (int ai = 0; ai < 2; ++ai)
#pragma unroll
                    for (int m = 0; m < 4; ++m) { const int row = row0 + ai * HALF + m * 16;
                        if (ai + m > 0) { const int pos = 1024 + ((row - 32768) & 31); const float* cq = rot + (size_t)pos * 64 + j0; const float* sq = cq + 16384 * 64;
                            c0 = *(const f32x4*)cq; c1 = *(const f32x4*)(cq + 4); s0 = *(const f32x4*)sq; s1 = *(const f32x4*)(sq + 4); }
                        emit(ai, m, row, 1.f); }
                return;
            }
#pragma unroll
            for (int ai = 0; ai < 2; ++ai)
#pragma unroll
                for (int m = 0; m < 4; ++m) { const int row = row0 + ai * HALF + m * 16;
                    if (ai == 1 && m == 0) {
#pragma unroll
                        for (int k = 0; k < 4; ++k) { const f32x4 t0 = c0 * dc0 - s0 * ds0, t1 = c1 * dc1 - s1 * ds1; s0 = s0 * dc0 + c0 * ds0; s1 = s1 * dc1 + c1 * ds1; c0 = t0; c1 = t1; } }
                    emit(ai, m, row, exp2f(lgs * (float)(row & 255)));
                    { const f32x4 t0 = c0 * dc0 - s0 * ds0, t1 = c1 * dc1 - s1 * ds1; s0 = s0 * dc0 + c0 * ds0; s1 = s1 * dc1 + c1 * ds1; c0 = t0; c1 = t1; } }
            return;
        }
        const bool hal = (u.pn >= 8 && u.pn < 14) && wr == 1;
#pragma unroll
        for (int ai = 0; ai < 2; ++ai)
#pragma unroll
            for (int m = 0; m < 4; ++m) { u32x4 w[2];
#pragma unroll
                for (int bj = 0; bj < 2; ++bj) { const f32x4 v0 = acc[ai][bj][m][0], v1 = acc[ai][bj][m][1];
                    w[bj].x = cvt_pk_bf16(v0[0], v0[1]); w[bj].y = cvt_pk_bf16(v0[2], v0[3]); w[bj].z = cvt_pk_bf16(v1[0], v1[1]); w[bj].w = cvt_pk_bf16(v1[2], v1[3]); }
                store_full_lines(O + (size_t)(u.pm * BM + ai * HALF + wr * 64 + m * 16) * ldc + u.pn * BM + 64 * wc, ldc, fr, fq, w[0], w[1],
                                 (ai == 1 && m == 3 && hal) ? halo + (size_t)(u.pm * 3) * 1536 + (u.pn * BM - 2048) + 64 * wc : nullptr, 1536); }
    }
    __device__ __forceinline__ int defer(const f32x4 (&acc)[2][2][4][2], const Unit& u, int wr, int wc, int fr, int fq, u32x4 (&dq)[8], char*& dbase, int& s1, int& s2, int& s4) const {
        asm volatile("" : "+v"(fr), "+v"(fq));
        const int row0 = u.pm * BM + wr * 64 + fr;
        if (u.pn >= 14 && u.pn < 22) {
            if (u.pm >= 128) { (*this)(acc, u, wr, wc, fr, fq); return 8; }
            const int seg = (u.pn < 18) ? 3584 : 4608, tile = (u.pn < 18) ? u.pn - 14 : u.pn - 18;
            const int head = 2 * tile + (wc >> 1), j0 = (wc & 1) * 32 + 8 * fq;
            const float lgs = ((u.pn < 18) ? 1.f : -1.f) * log2f(1.0f - exp2f(-5.0f - (float)head));
            const int pos0 = row0 & 16383;
            const float* cp = rot + (size_t)pos0 * 64 + j0; const float* sp = cp + 16384 * 64; const float* cd = rot + (size_t)16 * 64 + j0; const float* sd = cd + 16384 * 64;
            f32x4 c0 = *(const f32x4*)cp, c1 = *(const f32x4*)(cp + 4), s0 = *(const f32x4*)sp, s1v = *(const f32x4*)(sp + 4);
            const f32x4 dc0 = *(const f32x4*)cd, dc1 = *(const f32x4*)(cd + 4), ds0 = *(const f32x4*)sd, ds1 = *(const f32x4*)(sd + 4);
            bf16_t* rowp0 = O + (size_t)row0 * ldc + seg + 128 * head + j0;
#pragma unroll
            for (int ai = 0; ai < 2; ++ai)
#pragma unroll
                for (int m = 0; m < 4; ++m) { const int row = row0 + ai * HALF + m * 16;
                    if (ai == 1 && m == 0) {
#pragma unroll
                        for (int k = 0; k < 4; ++k) { const f32x4 t0 = c0 * dc0 - s0 * ds0, t1 = c1 * dc1 - s1v * ds1; s0 = s0 * dc0 + c0 * ds0; s1v = s1v * dc1 + c1 * ds1; c0 = t0; c1 = t1; } }
                    const float fac = exp2f(lgs * (float)(row & 255));
                    const f32x4 x1a = acc[ai][0][m][0], x1b = acc[ai][0][m][1], x2a = acc[ai][1][m][0], x2b = acc[ai][1][m][1];
                    const f32x4 o1a = (x1a * c0 - x2a * s0) * fac, o1b = (x1b * c1 - x2b * s1v) * fac, o2a = (x1a * s0 + x2a * c0) * fac, o2b = (x1b * s1v + x2b * c1) * fac;
                    u32x4 wa, wb; wa.x = cvt_pk_bf16(o1a[0], o1a[1]); wa.y = cvt_pk_bf16(o1a[2], o1a[3]); wa.z = cvt_pk_bf16(o1b[0], o1b[1]); wa.w = cvt_pk_bf16(o1b[2], o1b[3]);
                    wb.x = cvt_pk_bf16(o2a[0], o2a[1]); wb.y = cvt_pk_bf16(o2a[2], o2a[3]); wb.z = cvt_pk_bf16(o2b[0], o2b[1]); wb.w = cvt_pk_bf16(o2b[2], o2b[3]);
                    if (ai == 0) { bf16_t* rowp = rowp0 + (size_t)(m * 16) * ldc; __builtin_nontemporal_store(wa, (u32x4*)rowp); __builtin_nontemporal_store(wb, (u32x4*)(rowp + 64)); }
                    else { dq[2 * m] = wa; dq[2 * m + 1] = wb; }
                    { const f32x4 t0 = c0 * dc0 - s0 * ds0, t1 = c1 * dc1 - s1v * ds1; s0 = s0 * dc0 + c0 * ds0; s1v = s1v * dc1 + c1 * ds1; c0 = t0; c1 = t1; } }
            dbase = (char*)(rowp0 + (size_t)HALF * ldc);
            s1 = 128; s2 = 32 * ldc; s4 = 64 * ldc; return 0;
        }
        const bool hal = (u.pn >= 8 && u.pn < 14) && wr == 1;
        const int colo = (fr < 8 ? 0 : 32) + 8 * fq, r8 = fr & 7;
#pragma unroll
        for (int ai = 0; ai < 2; ++ai)
#pragma unroll
            for (int m = 0; m < 4; ++m) { u32x4 w[2];
#pragma unroll
                for (int bj = 0; bj < 2; ++bj) { const f32x4 v0 = acc[ai][bj][m][0], v1 = acc[ai][bj][m][1];
                    w[bj].x = cvt_pk_bf16(v0[0], v0[1]); w[bj].y = cvt_pk_bf16(v0[2], v0[3]); w[bj].z = cvt_pk_bf16(v1[0], v1[1]); w[bj].w = cvt_pk_bf16(v1[2], v1[3]); }
                if (ai == 0) store_full_lines(O + (size_t)(u.pm * BM + wr * 64 + m * 16) * ldc + u.pn * BM + 64 * wc, ldc, fr, fq, w[0], w[1]);
                else full_lines_pair(fr, w[0], w[1], dq[2 * m], dq[2 * m + 1]); }
        if (hal && r8 >= 5) *(u32x4*)(halo + (size_t)(u.pm * 3 + (r8 - 5)) * 1536 + (u.pn * BM - 2048) + 64 * wc + colo) = dq[7];
        dbase = (char*)(O + (size_t)(u.pm * BM + HALF + wr * 64 + r8) * ldc + u.pn * BM + 64 * wc + colo);
        s1 = 16 * ldc; s2 = 32 * ldc; s4 = 64 * ldc; return 0;
    }
};
struct EpiF32 {
    static constexpr bool PERM = false, AFTER_DRAIN = false, KSCALE = false;
    float* C; int ldc;
    __device__ __forceinline__ void operator()(const f32x4 (&acc)[2][2][4][2], const Unit& u, int wr, int wc, int fr, int fq) const {
        const int row0 = u.pm * BM + wr * 64 + fr, col0 = u.pn * BM + wc * 32 + 4 * fq;
#pragma unroll
        for (int ai = 0; ai < 2; ++ai)
#pragma unroll
            for (int m = 0; m < 4; ++m) { float* rowp = C + (size_t)(row0 + ai * HALF + m * 16) * ldc + col0;
#pragma unroll
                for (int bj = 0; bj < 2; ++bj)
#pragma unroll
                    for (int n = 0; n < 2; ++n) *(f32x4*)(rowp + bj * HALF + n * 16) = acc[ai][bj][m][n]; }
    }
};
__device__ __forceinline__ float silu_f(float x) { return x * __builtin_amdgcn_rcpf(1.0f + __builtin_amdgcn_exp2f(-1.4426950408889634f * x)); }
struct EpiSwiGLU {
    static constexpr bool PERM = true, AFTER_DRAIN = false, KSCALE = false;
    bf16_t* O; int ldc; const float* rs2;
    __device__ __forceinline__ void operator()(const f32x4 (&acc)[2][2][4][2], const Unit& u, int wr, int wc, int fr, int fq) const {
        const int row0 = u.pm * BM + wr * 64 + fr; const int col0 = u.pn * HALF + wc * 32 + 8 * fq;
        float rsv[2][4];
#pragma unroll
        for (int ai = 0; ai < 2; ++ai)
#pragma unroll
            for (int m = 0; m < 4; ++m) rsv[ai][m] = __hip_atomic_load(rs2 + row0 + ai * HALF + m * 16, __ATOMIC_RELAXED, __HIP_MEMORY_SCOPE_AGENT);
#pragma unroll
        for (int ai = 0; ai < 2; ++ai)
#pragma unroll
            for (int m = 0; m < 4; ++m) { bf16_t* rowp = O + (size_t)(row0 + ai * HALF + m * 16) * ldc + col0; const float rs = rsv[ai][m];
                const f32x4 g0 = acc[ai][0][m][0] * rs, g1 = acc[ai][0][m][1] * rs, u0 = acc[ai][1][m][0] * rs, u1 = acc[ai][1][m][1] * rs;
                u32x4 w; w.x = cvt_pk_bf16(silu_f(g0[0]) * u0[0], silu_f(g0[1]) * u0[1]); w.y = cvt_pk_bf16(silu_f(g0[2]) * u0[2], silu_f(g0[3]) * u0[3]);
                w.z = cvt_pk_bf16(silu_f(g1[0]) * u1[0], silu_f(g1[1]) * u1[1]); w.w = cvt_pk_bf16(silu_f(g1[2]) * u1[2], silu_f(g1[3]) * u1[3]);
                *(u32x4*)rowp = w; }
    }
    __device__ __forceinline__ int defer(const f32x4 (&acc)[2][2][4][2], const Unit& u, int wr, int wc, int fr, int fq, u32x4 (&dq)[8], char*& dbase, int& s1, int& s2, int& s4) const {
        asm volatile("" : "+v"(fr), "+v"(fq));
        const int row0 = u.pm * BM + wr * 64 + fr; const int col0 = u.pn * HALF + wc * 32 + 8 * fq;
        float rsv[2][4];
#pragma unroll
        for (int ai = 0; ai < 2; ++ai)
#pragma unroll
            for (int m = 0; m < 4; ++m) rsv[ai][m] = __hip_atomic_load(rs2 + row0 + ai * HALF + m * 16, __ATOMIC_RELAXED, __HIP_MEMORY_SCOPE_AGENT);
#pragma unroll
        for (int ai = 0; ai < 2; ++ai)
#pragma unroll
            for (int m = 0; m < 4; ++m) { const float rs = rsv[ai][m];
                const f32x4 g0 = acc[ai][0][m][0] * rs, g1 = acc[ai][0][m][1] * rs, u0 = acc[ai][1][m][0] * rs, u1 = acc[ai][1][m][1] * rs;
                u32x4 w; w.x = cvt_pk_bf16(silu_f(g0[0]) * u0[0], silu_f(g0[1]) * u0[1]); w.y = cvt_pk_bf16(silu_f(g0[2]) * u0[2], silu_f(g0[3]) * u0[3]);
                w.z = cvt_pk_bf16(silu_f(g1[0]) * u1[0], silu_f(g1[1]) * u1[1]); w.w = cvt_pk_bf16(silu_f(g1[2]) * u1[2], silu_f(g1[3]) * u1[3]);
                dq[ai * 4 + m] = w; }
        dbase = (char*)(O + (size_t)row0 * ldc + col0);
        s1 = 32 * ldc; s2 = 64 * ldc; s4 = 256 * ldc; return 0;
    }
};

struct SampleSplitOrder {
    int c, kh, ns;
    __device__ __forceinline__ bool next(int i, Unit& u) const { if (i > 0 || c >= 16 * ns) return false; const int t = c / ns; u.pm = 128 + (t >> 2); u.pn = t & 3; u.kb = (c % ns) * kh; return true; }
    __device__ __forceinline__ void a_ready(const Unit&) const {}
    __device__ __forceinline__ void done(const Unit&) const {}
};
struct EpiSlab {
    static constexpr bool PERM = false, AFTER_DRAIN = false, KSCALE = false;
    float* C; int kh;
    __device__ __forceinline__ void operator()(const f32x4 (&acc)[2][2][4][2], const Unit& u, int wr, int wc, int fr, int fq) const {
        float* base = C + (size_t)(u.kb / kh) * 1024 * 1024;
        const int row0 = (u.pm - 128) * BM + wr * 64 + fr, col0 = u.pn * BM + wc * 64 + 4 * fq;
#pragma unroll
        for (int ai = 0; ai < 2; ++ai)
#pragma unroll
            for (int m = 0; m < 4; ++m) { float* rowp = base + (size_t)(row0 + ai * HALF + m * 16) * 1024 + col0;
#pragma unroll
                for (int bj = 0; bj < 2; ++bj)
#pragma unroll
                    for (int n = 0; n < 2; ++n) *(f32x4*)(rowp + bj * 32 + n * 16) = acc[ai][bj][m][n]; }
    }
};
struct EpiSlabB {
    static constexpr bool PERM = true, AFTER_DRAIN = false, KSCALE = false;
    bf16_t* C; int kh, ld; size_t slab_stride;
    __device__ __forceinline__ void operator()(const f32x4 (&acc)[2][2][4][2], const Unit& u, int wr, int wc, int fr, int fq) const {
        bf16_t* base = C + (size_t)(u.kb / kh) * slab_stride;
#pragma unroll
        for (int ai = 0; ai < 2; ++ai)
#pragma unroll
            for (int m = 0; m < 4; ++m) { u32x4 w[2];
#pragma unroll
                for (int bj = 0; bj < 2; ++bj) { const f32x4 v0 = acc[ai][bj][m][0], v1 = acc[ai][bj][m][1];
                    w[bj].x = cvt_pk_bf16(v0[0], v0[1]); w[bj].y = cvt_pk_bf16(v0[2], v0[3]); w[bj].z = cvt_pk_bf16(v1[0], v1[1]); w[bj].w = cvt_pk_bf16(v1[2], v1[3]); }
                store_full_lines(base + (size_t)((u.pm - 128) * BM + ai * HALF + wr * 64 + m * 16) * ld + u.pn * BM + 64 * wc, ld, fr, fq, w[0], w[1]); }
    }
};
template <class Epi, class Sched, bool ALIGN_EPI = false, bool SP2 = false, bool DEFER = false>
__device__ __forceinline__ void gemm_phase(PG8_LAS unsigned char* lds, const Gemm g, const Sched& S, const Epi& E, int wave_id) {
    int tid = wave_id * 64 + hw_lane(); asm volatile("" : "+v"(tid));
    const int wid = __builtin_amdgcn_readfirstlane(tid >> 6), lane = tid & 63, wr = wid >> 2, wc = wid & 3, fr = lane & 15, fq = lane >> 4;
    const int K = g.K, nt = K / BK;
    unsigned voffA[2], voffB[2];
#pragma unroll
    for (int i = 0; i < 2; ++i) { int R, C; stage_rc(tid * 16 + i * 8192, R, C); const int Rb = Epi::PERM ? ((R & ~31) + perm32(R & 31)) : R;
        voffA[i] = (unsigned)(R * g.lda + C) * 2u; voffB[i] = (unsigned)(Rb * g.ldb + C) * 2u; }
    const size_t kstep = (size_t)(BK * 2);
    const size_t hstepA = (size_t)HALF * g.lda * 2, hstepB = (size_t)HALF * g.ldb * 2;
    const size_t tstepA = 2 * hstepA, tstepB = 2 * hstepB;
    const unsigned ldsw = (unsigned)wid * 1024u;
    const int aoff = lds_byte(wr * 64 + fr, fq * 8), boff = lds_byte(wc * 32 + fr, fq * 8);
#define PG8_SA(b, h) (((b) * 2 + (h)) * HTB)
#define PG8_SB(b, h) ((4 + (b) * 2 + (h)) * HTB)
#define PG8_STAGE(bufoff, gbase, voff) do { const char* gb_ = (const char*)(gbase); asm volatile("" : "+s"(gb_)); _Pragma("unroll") for (int _i = 0; _i < 2; ++_i) { unsigned vo_ = (voff)[_i]; asm volatile("" : "+v"(vo_));     \
        __builtin_amdgcn_global_load_lds((const unsigned*)(gb_ + vo_), (PG8_LAS unsigned*)(lds + (bufoff) + ldsw + _i * 8192), 16, 0, 0); } } while (0)
#define PG8_LDA(dst, b, h) do { _Pragma("unroll") for (int m = 0; m < 4; ++m) _Pragma("unroll") for (int k = 0; k < 2; ++k) dst[m][k] = *(const PG8_LAS bf16x8*)(lds + PG8_SA(b, h) + aoff + m * 2048 + k * 1024); } while (0)
#define PG8_LDB(dst, b, h) do { _Pragma("unroll") for (int n = 0; n < 2; ++n) _Pragma("unroll") for (int k = 0; k < 2; ++k) dst[n][k] = *(const PG8_LAS bf16x8*)(lds + PG8_SB(b, h) + boff + n * 2048 + k * 1024); } while (0)
#define PG8_MMA(ai, bj, At, Bt) do { __builtin_amdgcn_s_setprio(1); _Pragma("unroll") for (int m = 0; m < 4; ++m) _Pragma("unroll") for (int n = 0; n < 2; ++n) _Pragma("unroll") for (int k = 0; k < 2; ++k) \
        acc[ai][bj][m][n] = __builtin_amdgcn_mfma_f32_16x16x32_bf16(Bt[n][k], At[m][k], acc[ai][bj][m][n], 0, 0, 0); __builtin_amdgcn_s_setprio(0); } while (0)
#define PG8_WAIT_V(n) asm volatile("s_waitcnt vmcnt(" #n ")" ::: "memory")
#define PG8_WAIT_L(n) asm volatile("s_waitcnt lgkmcnt(" #n ")" ::: "memory")
#define PG8_BAR __builtin_amdgcn_s_barrier()
#define PG8_SCHED __builtin_amdgcn_sched_barrier(0)
    Unit cur, nxt; int ui = 0;
    if (!S.next(0, cur)) return;
    u32x4 dq[8]; char* dbase = nullptr; int ds1 = 0, ds2 = 0, ds4 = 0, dpend = 8;
    if constexpr (DEFER) {
#pragma unroll
        for (int j = 0; j < 8; ++j) dq[j] = (u32x4){0u, 0u, 0u, 0u}; }
#define PG8_DEFER_ONE() do { u32x4* p_ = (u32x4*)(dbase + ((dpend & 1) * ds1 + ((dpend >> 1) & 1) * ds2 + (dpend >> 2) * ds4)); \
        if (dpend == 0) __builtin_nontemporal_store(dq[0], p_); else if (dpend == 1) __builtin_nontemporal_store(dq[1], p_); else if (dpend == 2) __builtin_nontemporal_store(dq[2], p_); else if (dpend == 3) __builtin_nontemporal_store(dq[3], p_); \
        else if (dpend == 4) __builtin_nontemporal_store(dq[4], p_); else if (dpend == 5) __builtin_nontemporal_store(dq[5], p_); else if (dpend == 6) __builtin_nontemporal_store(dq[6], p_); else __builtin_nontemporal_store(dq[7], p_); ++dpend; } while (0)
    f32x4 acc[2][2][4][2];
#pragma unroll
    for (int a = 0; a < 2; ++a)
#pragma unroll
        for (int b = 0; b < 2; ++b)
#pragma unroll
            for (int m = 0; m < 4; ++m)
#pragma unroll
                for (int n = 0; n < 2; ++n) acc[a][b][m][n] = (f32x4){0.f, 0.f, 0.f, 0.f};
    bf16x8 At[4][2], B0[2][2], B1[2][2];
    const char* cA = (const char*)g.A + (size_t)cur.pm * tstepA + (size_t)cur.kb * (BK * 2); const char* cB = (const char*)g.Bt + (size_t)cur.pn * tstepB + (size_t)cur.kb * (BK * 2);
    S.a_ready(cur);
    if constexpr (SP2) {
        PG8_STAGE(PG8_SB(0, 0), cB, voffB); PG8_STAGE(PG8_SB(0, 1), cB + hstepB, voffB); PG8_STAGE(PG8_SA(0, 0), cA, voffA); PG8_STAGE(PG8_SA(0, 1), cA + hstepA, voffA);
        if (wr == 1) PG8_BAR;
        PG8_WAIT_V(2); PG8_BAR;
        PG8_STAGE(PG8_SB(1, 0), cB + kstep, voffB); PG8_STAGE(PG8_SA(1, 0), cA + kstep, voffA); PG8_STAGE(PG8_SB(1, 1), cB + hstepB + kstep, voffB);
        PG8_WAIT_V(6); PG8_BAR;
    } else {
        PG8_STAGE(PG8_SB(0, 0), cB, voffB); PG8_STAGE(PG8_SA(0, 0), cA, voffA); PG8_STAGE(PG8_SB(0, 1), cB + hstepB, voffB); PG8_STAGE(PG8_SA(0, 1), cA + hstepA, voffA);
        if (wr == 1) PG8_BAR;
        PG8_WAIT_V(4); PG8_BAR;
        PG8_STAGE(PG8_SB(1, 0), cB + kstep, voffB); PG8_STAGE(PG8_SA(1, 0), cA + kstep, voffA); PG8_STAGE(PG8_SB(1, 1), cB + hstepB + kstep, voffB);
        PG8_WAIT_V(6); PG8_BAR;
    }
    const bool pr_ = PROBE && blockIdx.x == 0 && wid == 0 && g.N == 6912;
    unsigned acck_ = 0;
    for (;;) {
        unsigned pt0_ = 0; if (pr_) pt0_ = (unsigned)__builtin_amdgcn_s_memrealtime();
        const bool has_next = S.next(ui + 1, nxt);
        const char* nA = has_next ? (const char*)g.A + (size_t)nxt.pm * tstepA + (size_t)nxt.kb * (BK * 2) : cA; const char* nB = has_next ? (const char*)g.Bt + (size_t)nxt.pn * tstepB + (size_t)nxt.kb * (BK * 2) : cB;
        for (int t = 0; t < nt; t += 2) {
            const bool last = (t == nt - 2);
            const char* a1 = cA + (size_t)(t + 1) * kstep;
            const char* a2 = last ? nA : cA + (size_t)(t + 2) * kstep; const char* b2 = last ? nB : cB + (size_t)(t + 2) * kstep;
            const char* a3 = a2 + kstep; const char* b3 = b2 + kstep;
            if (last && has_next) S.a_ready(nxt);
            if constexpr (Epi::KSCALE) { if (t == 8 || t == 16) E.kscale(acc, cur, wr, fr, t == 8 ? 0 : 1); }
            if constexpr (SP2) {
#define PG8_WAIT_V89() do { if (st_) PG8_WAIT_V(9); else PG8_WAIT_V(8); } while (0)
            const bool st_ = DEFER && dpend < 8;
            PG8_LDB(B0, 0, 0); PG8_LDB(B1, 0, 1); PG8_SCHED; PG8_LDA(At, 0, 0); PG8_STAGE(PG8_SA(1, 1), a1 + hstepA, voffA); if constexpr (DEFER) { if (st_) PG8_DEFER_ONE(); }
            PG8_WAIT_V89(); PG8_WAIT_L(0); PG8_BAR; PG8_MMA(0, 0, At, B0); PG8_MMA(0, 1, At, B1); PG8_BAR; PG8_SCHED;
            PG8_LDA(At, 0, 1); PG8_STAGE(PG8_SB(0, 0), b2, voffB); PG8_STAGE(PG8_SB(0, 1), b2 + hstepB, voffB); PG8_STAGE(PG8_SA(0, 0), a2, voffA);
            PG8_WAIT_V89(); PG8_WAIT_L(0); PG8_BAR; PG8_MMA(1, 0, At, B0); PG8_MMA(1, 1, At, B1); PG8_BAR; PG8_SCHED;
            PG8_LDB(B0, 1, 0); PG8_LDB(B1, 1, 1); PG8_SCHED; PG8_LDA(At, 1, 0); PG8_STAGE(PG8_SA(0, 1), a2 + hstepA, voffA);
            PG8_WAIT_V89(); PG8_WAIT_L(0); PG8_BAR; PG8_MMA(0, 0, At, B0); PG8_MMA(0, 1, At, B1); PG8_BAR; PG8_SCHED;
            PG8_LDA(At, 1, 1); PG8_STAGE(PG8_SB(1, 0), b3, voffB); PG8_STAGE(PG8_SB(1, 1), b3 + hstepB, voffB); PG8_STAGE(PG8_SA(1, 0), a3, voffA);
            PG8_WAIT_V(8); PG8_WAIT_L(0); PG8_BAR; PG8_MMA(1, 0, At, B0); PG8_MMA(1, 1, At, B1); PG8_BAR; PG8_SCHED;
#undef PG8_WAIT_V89
            } else {
            PG8_LDB(B0, 0, 0); PG8_SCHED; PG8_LDA(At, 0, 0); PG8_STAGE(PG8_SA(1, 1), a1 + hstepA, voffA);
            PG8_WAIT_L(8); PG8_BAR; PG8_WAIT_L(0); PG8_MMA(0, 0, At, B0); PG8_BAR; PG8_SCHED;
            PG8_LDB(B1, 0, 1); PG8_STAGE(PG8_SB(0, 0), b2, voffB);
            PG8_BAR; PG8_WAIT_L(0); PG8_MMA(0, 1, At, B1); PG8_BAR;
            PG8_LDA(At, 0, 1); PG8_STAGE(PG8_SA(0, 0), a2, voffA);
            PG8_BAR; PG8_WAIT_L(0); PG8_MMA(1, 0, At, B0); PG8_BAR; PG8_SCHED;
            PG8_STAGE(PG8_SB(0, 1), b2 + hstepB, voffB);
            PG8_WAIT_V(6); PG8_BAR; PG8_MMA(1, 1, At, B1); PG8_BAR;
            PG8_LDB(B0, 1, 0); PG8_SCHED; PG8_LDA(At, 1, 0); PG8_STAGE(PG8_SA(0, 1), a2 + hstepA, voffA);
            PG8_WAIT_L(8); PG8_BAR; PG8_WAIT_L(0); PG8_MMA(0, 0, At, B0); PG8_BAR; PG8_SCHED;
            PG8_LDB(B1, 1, 1); PG8_STAGE(PG8_SB(1, 0), b3, voffB);
            PG8_BAR; PG8_WAIT_L(0); PG8_MMA(0, 1, At, B1); PG8_BAR;
            PG8_LDA(At, 1, 1); PG8_STAGE(PG8_SA(1, 0), a3, voffA);
            PG8_BAR; PG8_WAIT_L(0); PG8_MMA(1, 0, At, B0); PG8_BAR; PG8_SCHED;
            PG8_STAGE(PG8_SB(1, 1), b3 + hstepB, voffB);
            PG8_WAIT_V(6); PG8_BAR; PG8_MMA(1, 1, At, B1); PG8_BAR;
            }
        }
        unsigned pt1_ = 0; if (pr_) { pt1_ = (unsigned)__builtin_amdgcn_s_memrealtime(); acck_ += pt1_ - pt0_; }
        if constexpr (ALIGN_EPI) { if (wr == 0) PG8_BAR; }
        if constexpr (DEFER) { while (dpend < 8) PG8_DEFER_ONE(); dpend = E.defer(acc, cur, wr, wc, fr, fq, dq, dbase, ds1, ds2, ds4); S.done(cur); } else
        if constexpr (!Epi::AFTER_DRAIN) { E(acc, cur, wr, wc, fr, fq); S.done(cur); }
        if (!has_next) break;
#pragma unroll
        for (int a = 0; a < 2; ++a)
#pragma unroll
            for (int b = 0; b < 2; ++b)
#pragma unroll
                for (int m = 0; m < 4; ++m)
#pragma unroll
                    for (int n = 0; n < 2; ++n) acc[a][b][m][n] = (f32x4){0.f, 0.f, 0.f, 0.f};
        cur = nxt; cA = nA; cB = nB; ++ui;
        if constexpr (ALIGN_EPI) { if (wr == 1) PG8_BAR; }
    }
    if constexpr (DEFER) { while (dpend < 8) PG8_DEFER_ONE(); }
    if (pr_) { *PROBE_LDS_WORD(24) = acck_; }
    PG8_WAIT_V(0);
    if constexpr (!ALIGN_EPI) { if (wr == 0) PG8_BAR; }
    PG8_BAR;
    if constexpr (Epi::AFTER_DRAIN) { E.fused(acc, cur, wr, wc, fr, fq, lds, wid, lane); S.done(cur); }
#undef PG8_DEFER_ONE
#undef PG8_SA
#undef PG8_SB
#undef PG8_STAGE
#undef PG8_LDA
#undef PG8_LDB
#undef PG8_MMA
#undef PG8_WAIT_V
#undef PG8_WAIT_L
#undef PG8_BAR
#undef PG8_SCHED
}
}

#define GAS __attribute__((address_space(1)))
#define LAS __attribute__((address_space(3)))
typedef unsigned short bf16;
typedef unsigned v4u __attribute__((ext_vector_type(4)));
typedef float f32x4 __attribute__((ext_vector_type(4)));
typedef short bf16x8 __attribute__((ext_vector_type(8)));
typedef GAS unsigned gu32;
typedef GAS unsigned long long gu64;
#define RLX_AGENT __ATOMIC_RELAXED, __HIP_MEMORY_SCOPE_AGENT
#define LDS_WAIT() asm volatile("s_waitcnt lgkmcnt(0)" ::: "memory")
#define VM_WAIT() asm volatile("s_waitcnt vmcnt(0)" ::: "memory")
__device__ __forceinline__ unsigned long long rt() { return __builtin_amdgcn_s_memrealtime(); }
__device__ __forceinline__ unsigned f2bf(float f) { unsigned u = __builtin_bit_cast(unsigned, f); return (u + 0x7fffu + ((u >> 16) & 1u)) >> 16; }
__device__ __forceinline__ unsigned pk2(float lo, float hi) { return f2bf(lo) | (f2bf(hi) << 16); }
__device__ __forceinline__ unsigned pkh(float lo, float hi) { typedef float f2_t __attribute__((ext_vector_type(2))); typedef __bf16 b2_t __attribute__((ext_vector_type(2))); f2_t v = {lo, hi}; b2_t b = __builtin_convertvector(v, b2_t); return __builtin_bit_cast(unsigned, b); }

#define XB_TMO      128
#define XB_XCNT(j)  (256  + 64 * (j))
#define XB_XSUB(j)  (1280 + 64 * (j))
#define XB_XGEN(j)  (2304 + 64 * (j))
#define XB_TOP      3328
#define XB_TOPGEN   3392
#define XCD_BAR_WORDS 3456
#define XB_SPIN_CAP (1u << 18)

__device__ __forceinline__ unsigned xb_ld(unsigned* p)              { return __hip_atomic_load(p, __ATOMIC_RELAXED, __HIP_MEMORY_SCOPE_AGENT); }
__device__ __forceinline__ unsigned xb_add(unsigned* p, unsigned v) { return __hip_atomic_fetch_add(p, v, __ATOMIC_RELAXED, __HIP_MEMORY_SCOPE_AGENT); }
__device__ __forceinline__ unsigned xb_xcc_id() { return (unsigned)__builtin_amdgcn_s_getreg((3 << 11) | 20) & 0xFu; }
#define XB_SPIN(cond, bar) do { unsigned _sp = 0; while (cond) { __builtin_amdgcn_s_sleep(1); \
    if ((++_sp & 255u) == 0u) { if (xb_ld(&(bar)[XB_TMO])) break; if (_sp > XB_SPIN_CAP) { atomicAdd(&(bar)[XB_TMO], 1u); break; } } } } while (0)

struct XcdBarrier {
    unsigned* bar; unsigned x; int wave;
    volatile LAS unsigned* st;
};

__device__ __forceinline__ XcdBarrier xcd_barrier_post(unsigned* bar, volatile LAS unsigned* st, int wave) {
    XcdBarrier b; b.bar = bar; b.x = xb_xcc_id(); b.st = st; b.wave = wave;
    if (wave == 0 && hw_lane() == 0) (void)xb_add(&bar[XB_XCNT(b.x)], 1u);
    return b;
}
__device__ __forceinline__ void xcd_barrier_complete(unsigned* bar, unsigned x, unsigned& nloc, unsigned& nx) {
    const unsigned G = gridDim.x * gridDim.y * gridDim.z;
    unsigned sum, cnt, mine, sp = 0u;
    for (;;) {
        sum = 0u; cnt = 0u; mine = 0u;
#pragma unroll
        for (unsigned j = 0; j < 16; ++j) { const unsigned c = xb_ld(&bar[XB_XCNT(j)]); sum += c; cnt += (c > 0u) ? 1u : 0u; mine = (j == x) ? c : mine; }
        if (sum == G) break;
        __builtin_amdgcn_s_sleep(1);
        if ((++sp & 255u) == 0u) { if (xb_ld(&bar[XB_TMO])) break; if (sp > XB_SPIN_CAP) { atomicAdd(&bar[XB_TMO], 1u); break; } }
    }
    nloc = mine > 0u ? mine : 1u; nx = cnt > 0u ? cnt : 1u;
}

__device__ __forceinline__ void xcd_barrier(const XcdBarrier& b) {
    asm volatile("s_waitcnt vmcnt(0)" ::: "memory");
    __syncthreads();
    if (b.wave == 0 && hw_lane() == 0) {
        unsigned* bar = b.bar;
        __builtin_amdgcn_s_waitcnt(0);
        unsigned nloc = b.st[0], nx = b.st[1];
        if (nloc == 0u) { xcd_barrier_complete(bar, b.x, nloc, nx); b.st[0] = nloc; b.st[1] = nx; }
        const unsigned old = xb_add(&bar[XB_XSUB(b.x)], 1u);
        const unsigned gen = old / nloc;
        if (old + 1u == (gen + 1u) * nloc) {
            __builtin_amdgcn_fence(__ATOMIC_RELEASE, "agent");
            asm volatile("s_waitcnt vmcnt(0)" ::: "memory");
            const unsigned og = xb_add(&bar[XB_TOP], 1u);
            const unsigned tg = og / nx;
            if (og + 1u == (tg + 1u) * nx) xb_add(&bar[XB_TOPGEN], 1u);
            else XB_SPIN(xb_ld(&bar[XB_TOPGEN]) == tg, bar);
            __builtin_amdgcn_fence(__ATOMIC_ACQUIRE, "agent");
            xb_add(&bar[XB_XGEN(b.x)], 1u);
            asm volatile("s_waitcnt vmcnt(0)" ::: "memory");
        } else {
            XB_SPIN(xb_ld(&bar[XB_XGEN(b.x)]) == gen, bar);
            __builtin_amdgcn_fence(__ATOMIC_ACQUIRE, "agent");
            asm volatile("s_waitcnt vmcnt(0)" ::: "memory");
        }
    }
    __syncthreads();
}


constexpr int PA_FROM = 30, PA_TO = 24, PB_FROM = 1, PB_TO = 2; constexpr float PA_DMAX = 400.f, PB_DMAX = 2000.f;
constexpr int NWAVES = 8, NTHR = 512;
constexpr int DM = 1024, PB = 2, PL = 16384, SBN = 32, SL = 32, PASTLEN = 1024;
constexpr int RP = PB * PL;
constexpr int RS = SBN * SL;
constexpr int RT = RP + RS;
constexpr int NPANEL = RT / 256, NPP = RP / 256;
constexpr int DSSM = 1024, NH = 16, HP = 64, NG = 2, NST = 128, CONVD = 1536;
constexpr int DRET = 1024, RH = 8, RD = 128;
constexpr int DFF = 2816, NIN = 6672;
constexpr int LP = 6912, Z0 = 0, G0 = 1024, XBC0 = 2048, XB0 = XBC0 + 1024, XC0 = XBC0 + 1280, Q0 = 3584, K0 = 4608, V0 = 5632, DT0 = 6656;
constexpr int X1_0 = 1024;
constexpr int HF0 = 2048;
constexpr int ACT0 = 3072;
constexpr int RAW2_0 = 3584;
constexpr size_t C_RAW2 = 0, C_SLAB2 = (size_t)32768 * 1024;
constexpr size_t C_X1 = 0, C_ACT = (size_t)33792 * 1024, C_RAW4 = C_ACT + (size_t)33792 * 2816, C_SLAB4 = C_RAW4 + (size_t)32768 * 1024;
static_assert((C_SLAB4 + (size_t)11 * 1024 * 1024) <= (size_t)33792 * 6912 && (C_SLAB2 + (size_t)4 * 1024 * 1024) * 2 <= (size_t)33792 * 1024 * 4, "compact buffers fit");
constexpr float EPS = 1e-6f;

constexpr size_t MiB = 1u << 20;
constexpr size_t WS_CTL = 0, CTL_ZERO_BYTES = 1 * MiB;
constexpr size_t WS_W1 = 1 * MiB;
constexpr size_t WS_W2 = 16 * MiB;
constexpr size_t WS_W3 = 20 * MiB;
constexpr size_t WS_W4 = 31 * MiB;
constexpr size_t WS_MISC = 37 * MiB;
constexpr size_t WS_PROJ = 48 * MiB;
constexpr size_t WS_ROT = WS_PROJ + (size_t)RT * LP * 2;
constexpr size_t WS_HALO = WS_ROT + (size_t)2 * PL * 64 * 4;
constexpr size_t WS_SLAB = (WS_HALO + (size_t)NPANEL * 3 * CONVD * 2 + 255) / 256 * 256;
constexpr size_t WS_END = WS_SLAB + (size_t)2 * RS * DM * 4;
static_assert(WS_END <= 512 * MiB && WS_ROT % 256 == 0 && WS_HALO % 256 == 0, "d_ws map");
constexpr size_t MS_SSQ = 0;
constexpr size_t MS_DEC = MS_SSQ + (size_t)RT * 16;
constexpr size_t MS_DT = MS_DEC + (size_t)NPP * 16;
constexpr size_t MS_ACUM = MS_DT + (size_t)RT * 16;
constexpr size_t MS_RS2 = MS_ACUM + (size_t)RT * 16;
constexpr size_t MS_GRS = MS_RS2 + (size_t)RT;
constexpr size_t MS_END = MS_GRS + (size_t)RP * 2;
static_assert(MS_END * 4 <= 11 * MiB, "misc map");
constexpr size_t O_YP = 0, O_YS = (size_t)RP * DM, O_CP = O_YS + (size_t)RS * DM, O_SP = O_CP + (size_t)PB * 3 * CONVD, O_RP = O_SP + (size_t)PB * NH * HP * NST,
                 O_CS = O_RP + (size_t)PB * RH * RD * RD, O_SS = O_CS + (size_t)SBN * 3 * CONVD, O_RS = O_SS + (size_t)SBN * NH * HP * NST, O_END = O_RS + (size_t)SBN * RH * RD * RD;
static_assert(O_END == 43672576, "d_out map");
constexpr size_t ST_SSD = 0;
constexpr size_t ST_RET = (size_t)NPP * NH * NST * HP;
static_assert((ST_RET + (size_t)NPP * RH * RD * RD) * 2 <= (size_t)RT * DM * 4, "state scratch fits the y region");

constexpr int CW_TMO = 0, CW_CODE = 1;
constexpr int CW_BAR = 4096;

constexpr int RING_OFF = 0, RING_BYTES = 131072;
constexpr int LDS_BYTES = 163840;
constexpr int LDSCTL_OFF = LDS_BYTES - 512, MISC_OFF = LDSCTL_OFF + 320;
constexpr int SCAN_LDS = LDSCTL_OFF;
static_assert(MISC_OFF + 128 <= LDS_BYTES, "LDS map");

struct Frame {
    LAS unsigned char* lds;
    volatile LAS unsigned* MISC;
    gu32* ctl;
    int tid, lane, wave;
    int vcu, G;
    const float *xp, *xs, *st_conv, *st_ssm, *st_ret, *n_mix_pre, *n_mix_post, *n_ffn_pre, *n_ffn_post, *w_in, *conv_w, *conv_b, *dt_bias, *a_log, *d_skip, *ssm_norm, *ret_norm, *w_out, *w_gate, *w_up, *w_down;
    float* out;
    bf16 *W1t, *W2t, *W3t, *W4t, *PROJ, *HB;
    float* misc; float* rot; bf16* halo; float* slab;
};
__device__ __forceinline__ float wave_sum(float v) {
#pragma unroll
    for (int o = 1; o < 64; o <<= 1) v += __shfl_xor(v, o);
    return v;
}
__device__ __forceinline__ const float* x_row(const Frame& F, int r) { return r < RP ? F.xp + (size_t)r * DM : F.xs + (size_t)(r - RP) * DM; }

__device__ const double ROT_REV[64] = {
0.15915494309189535, 0.13782250260398285, 0.11934937021124886, 0.10335229661843406,
0.08949940160889101, 0.07750328875537406, 0.06711508300522726, 0.058119267441876246,
0.050329212104487035, 0.04358330210530733, 0.03774158471741977, 0.032682865872357,
0.0283021958306234, 0.024508691862069852, 0.02122365276477766, 0.018378926105679667,
0.015915494309189534, 0.013782250260398284, 0.011934937021124886, 0.010335229661843406,
0.008949940160889102, 0.0077503288755374055, 0.006711508300522725, 0.005811926744187624,
0.005032921210448704, 0.004358330210530733, 0.003774158471741977, 0.0032682865872356993,
0.00283021958306234, 0.002450869186206985, 0.0021223652764777662, 0.0018378926105679667,
0.0015915494309189536, 0.0013782250260398288, 0.0011934937021124885, 0.0010335229661843405,
0.0008949940160889102, 0.0007750328875537405, 0.0006711508300522726, 0.0005811926744187624,
0.0005032921210448703, 0.0004358330210530733, 0.00037741584717419774, 0.0003268286587235699,
0.00028302195830623395, 0.00024508691862069854, 0.0002122365276477766, 0.00018378926105679666,
0.00015915494309189535, 0.00013782250260398286, 0.00011934937021124886, 0.00010335229661843406,
8.949940160889102e-05, 7.750328875537406e-05, 6.711508300522725e-05, 5.811926744187624e-05,
5.0329212104487035e-05, 4.358330210530732e-05, 3.774158471741978e-05, 3.2682865872357e-05,
2.8302195830623396e-05, 2.4508691862069852e-05, 2.122365276477766e-05, 1.8378926105679668e-05
};
__device__ __forceinline__ int dst_row(int mode, int n) {
    if (mode == 1) {
        int pos;
        if (n < 1024) pos = Z0 + n;
        else if (n < 2560) pos = XBC0 + (n - 1024);
        else if (n < 2576) pos = DT0 + (n - 2560);
        else if (n < 4624) { const int seg = (n < 3600) ? Q0 : K0, c = (n < 3600) ? n - 2576 : n - 3600, head = c >> 7, d = c & 127;
            return seg + 256 * (head >> 1) + 128 * (d >> 6) + 64 * (head & 1) + (d & 63); }
        else if (n < 5648) pos = V0 + (n - 4624);
        else pos = G0 + (n - 5648);
        return pg8::tile_perm(pos);
    }
    if (mode == 2) return 256 * (n >> 7) + (n & 127);
    if (mode == 3) return 256 * (n >> 7) + 128 + (n & 127);
    return pg8::tile_perm(n);
}
__device__ __forceinline__ void p0_transpose_item(const float* W, int K, int N, bf16* WT, int mode, const float* ks0, const float* ks1, int ksplit, LAS float* scr, int item, int lane) {
    const int nblk = (N + 31) / 32, kb = item / nblk, nb = item % nblk, k0 = 64 * kb, n0 = 32 * nb;
    { const int q4 = 4 * (lane & 7); f32x4 v[8];
#pragma unroll
      for (int i = 0; i < 8; ++i) { const int kk = 8 * i + (lane >> 3); v[i] = (n0 + q4 < N) ? __builtin_nontemporal_load((const GAS f32x4*)(W + (size_t)(k0 + kk) * N + n0 + q4)) : (f32x4){0.f, 0.f, 0.f, 0.f}; }
#pragma unroll
      for (int i = 0; i < 8; ++i) { const int kk = 8 * i + (lane >> 3); LAS float* d = scr + kk * 33 + q4; d[0] = v[i][0]; d[1] = v[i][1]; d[2] = v[i][2]; d[3] = v[i][3]; } }
    LDS_WAIT(); asm volatile("" ::: "memory");
    const int c = lane & 7;
    float sc[8];
#pragma unroll
    for (int i = 0; i < 8; ++i) { const int k = k0 + 8 * c + i; sc[i] = ks0 ? (k < ksplit ? ks0[k] : ks1[k - ksplit]) : 1.f; }
#pragma unroll
    for (int j = 0; j < 4; ++j) { const int n = (lane >> 3) + 8 * j; const LAS float* s = scr + (8 * c) * 33 + n;
        const float cs = (mode == 1 && n0 + n >= 3600 && n0 + n < 4624) ? 0.08838834764831845f : 1.f;
        v4u o; o.x = pk2(s[0 * 33] * sc[0] * cs, s[1 * 33] * sc[1] * cs); o.y = pk2(s[2 * 33] * sc[2] * cs, s[3 * 33] * sc[3] * cs); o.z = pk2(s[4 * 33] * sc[4] * cs, s[5 * 33] * sc[5] * cs); o.w = pk2(s[6 * 33] * sc[6] * cs, s[7 * 33] * sc[7] * cs);
        if (n0 + n < N) *(GAS v4u*)(WT + (size_t)dst_row(mode, n0 + n) * K + k0 + 8 * c) = o; }
    LDS_WAIT(); asm volatile("" ::: "memory");
}
__device__ __forceinline__ void rms_row_to_bf16(const Frame& F, const float* xrow, bf16* orow) {
    const GAS f32x4* xr = (const GAS f32x4*)xrow + F.lane;
    f32x4 v[4]; float s2 = 0.f;
#pragma unroll
    for (int j = 0; j < 4; ++j) { v[j] = xr[64 * j]; s2 += (v[j].x * v[j].x + v[j].y * v[j].y) + (v[j].z * v[j].z + v[j].w * v[j].w); }
    const float rs = 1.0f / sqrtf(wave_sum(s2) * (1.f / DM) + EPS);
    GAS unsigned long long* o8 = (GAS unsigned long long*)orow + F.lane;
#pragma unroll
    for (int j = 0; j < 4; ++j) o8[64 * j] = (unsigned long long)pk2(v[j].x * rs, v[j].y * rs) | ((unsigned long long)pk2(v[j].z * rs, v[j].w * rs) << 32);
}
__device__ __forceinline__ void p0_prologue(Frame& F) {
    LAS float* scr = (LAS float*)(F.lds + RING_OFF + F.wave * 16384);
    const int gw = F.vcu * NWAVES + F.wave, NGW = F.G * NWAVES;
    constexpr int I_1 = (DM / 64) * ((NIN + 31) / 32), I_2 = (2048 / 64) * (DM / 32), I_3 = (DM / 64) * (DFF / 32), I_4 = (DFF / 64) * (DM / 32);
    constexpr int NITEMS = I_1 + I_2 + 2 * I_3 + I_4;
    for (int it = gw; it < NITEMS; it += NGW) {
        int r = it;
        if (r < I_1) { p0_transpose_item(F.w_in, DM, NIN, F.W1t, 1, F.n_mix_pre, F.n_mix_pre, DM, scr, r, F.lane); continue; } r -= I_1;
        if (r < I_2) { p0_transpose_item(F.w_out, 2048, DM, F.W2t, 0, F.ssm_norm, F.ret_norm, DSSM, scr, r, F.lane); continue; } r -= I_2;
        if (r < I_3) { p0_transpose_item(F.w_gate, DM, DFF, F.W3t, 2, F.n_ffn_pre, F.n_ffn_pre, DM, scr, r, F.lane); continue; } r -= I_3;
        if (r < I_3) { p0_transpose_item(F.w_up, DM, DFF, F.W3t, 3, F.n_ffn_pre, F.n_ffn_pre, DM, scr, r, F.lane); continue; } r -= I_3;
        p0_transpose_item(F.w_down, DFF, DM, F.W4t, 0, nullptr, nullptr, 0, scr, r, F.lane);
    }
    { GAS v4u* z = (GAS v4u*)(F.W1t + (size_t)(DT0 + 16) * DM); const int n16 = (LP - DT0 - 16) * DM * 2 / 16;
      for (int i = gw * 64 + F.lane; i < n16; i += NGW * 64) z[i] = (v4u){0u, 0u, 0u, 0u}; }
    for (int i = gw * 64 + F.lane; i < PL * 64; i += NGW * 64) { const int pos = i >> 6, j = i & 63;
        const double rev = (double)pos * ROT_REV[j]; const float fr = (float)(rev - __builtin_floor(rev));
        F.rot[i] = __builtin_amdgcn_cosf(fr); F.rot[PL * 64 + i] = __builtin_amdgcn_sinf(fr); }
    for (int m2 = gw; m2 < RT / 2; m2 += NGW) { const int ma = 2 * m2, mb = ma + 1;
        const GAS f32x4* xa = (const GAS f32x4*)x_row(F, ma) + F.lane; const GAS f32x4* xb = (const GAS f32x4*)x_row(F, mb) + F.lane;
        f32x4 va[4], vb[4]; float sa = 0.f, sb = 0.f;
#pragma unroll
        for (int j = 0; j < 4; ++j) { va[j] = __builtin_nontemporal_load(xa + 64 * j); vb[j] = __builtin_nontemporal_load(xb + 64 * j); }
#pragma unroll
        for (int j = 0; j < 4; ++j) { sa += (va[j].x * va[j].x + va[j].y * va[j].y) + (va[j].z * va[j].z + va[j].w * va[j].w); sb += (vb[j].x * vb[j].x + vb[j].y * vb[j].y) + (vb[j].z * vb[j].z + vb[j].w * vb[j].w); }
#pragma unroll
        for (int o = 1; o < 64; o <<= 1) { sa += __shfl_xor(sa, o); sb += __shfl_xor(sb, o); }
        const float ra = 1.0f / sqrtf(sa * (1.f / DM) + EPS), rb = 1.0f / sqrtf(sb * (1.f / DM) + EPS);
        GAS unsigned long long* oa = (GAS unsigned long long*)(F.HB + (size_t)ma * DM) + F.lane; GAS unsigned long long* ob = (GAS unsigned long long*)(F.HB + (size_t)mb * DM) + F.lane;
#pragma unroll
        for (int j = 0; j < 4; ++j) { oa[64 * j] = (unsigned long long)pkh(va[j].x * ra, va[j].y * ra) | ((unsigned long long)pkh(va[j].z * ra, va[j].w * ra) << 32);
            ob[64 * j] = (unsigned long long)pkh(vb[j].x * rb, vb[j].y * rb) | ((unsigned long long)pkh(vb[j].z * rb, vb[j].w * rb) << 32); }
    }
}

typedef float f32x4v __attribute__((ext_vector_type(4)));
__device__ __forceinline__ float bf2f(unsigned short b) { return __builtin_bit_cast(float, (unsigned)b << 16); }
__device__ __forceinline__ float bflo(unsigned w) { return __builtin_bit_cast(float, w << 16); }
__device__ __forceinline__ float bfhi(unsigned w) { return __builtin_bit_cast(float, w & 0xffff0000u); }
__device__ __forceinline__ float silu(float x) { return x * __builtin_amdgcn_rcpf(1.0f + __expf(-x)); }
__device__ __forceinline__ void bar_sync() { __syncthreads(); }
__device__ __forceinline__ void lds_barrier() { asm volatile("s_waitcnt lgkmcnt(0)" ::: "memory"); __builtin_amdgcn_s_barrier(); asm volatile("" ::: "memory"); }
__device__ __forceinline__ f32x4 mma_tile(const LAS bf16* A, int pa, const LAS bf16* B, int pb, int K, f32x4 acc, int lane) {
    const int r = lane & 15, q = lane >> 4;
    const LAS bf16* ap = A + r * pa + 8 * q; const LAS bf16* bp = B + r * pb + 8 * q;
    for (int k0 = 0; k0 < K; k0 += 32) {
        const bf16x8 a = *(const LAS bf16x8*)(ap + k0), b = *(const LAS bf16x8*)(bp + k0);
        acc = __builtin_amdgcn_mfma_f32_16x16x32_bf16(a, b, acc, 0, 0, 0);
    }
    return acc;
}
struct SeqInfo { int r0; int tseq0; int pos0; int sb; };

__device__ __forceinline__ void conv_pair(const Frame& F, const SeqInfo& si, int t, int c, float& o0, float& o1) {
    const unsigned w = *(const GAS unsigned*)(F.PROJ + (size_t)(si.r0 + t) * LP + XBC0 + c); o0 = bflo(w); o1 = bfhi(w);
}
__device__ __forceinline__ float softplus_f(float x) { return fmaxf(x, 0.f) + log1pf(__expf(-fabsf(x))); }

constexpr int SP_A = 136, SP_T = 72;
constexpr int SS_CM = 0, SS_BM = SS_CM + 64 * SP_A * 2, SS_BT = SS_BM + 64 * SP_A * 2, SS_XT = SS_BT + 128 * SP_T * 2, SS_XW = SS_XT + 64 * SP_T * 2, SS_MM = SS_XW + 64 * SP_T * 2,
              SS_HB = SS_MM + 64 * SP_T * 2, SS_YT = SS_HB + 64 * SP_A * 2, SS_VEC = SS_YT + 64 * 65 * 4, SS_END = SS_VEC + 6 * 256 * 4;
static_assert(SS_END <= RING_BYTES, "ssd LDS map");

template <int T, int NCH, int MODE>
__device__ __forceinline__ void ssd_unit(Frame& F, const SeqInfo si, const int e, const int sidx) {
    LAS unsigned char* L = F.lds + RING_OFF;
    LAS bf16* Cm = (LAS bf16*)(L + SS_CM); LAS bf16* Bm = (LAS bf16*)(L + SS_BM); LAS bf16* Bt = (LAS bf16*)(L + SS_BT); LAS bf16* Xt = (LAS bf16*)(L + SS_XT);
    LAS bf16* Xw = (LAS bf16*)(L + SS_XW); LAS bf16* Mm = (LAS bf16*)(L + SS_MM); LAS bf16* Hb = (LAS bf16*)(L + SS_HB); LAS float* Yt = (LAS float*)(L + SS_YT);
    LAS float* dtv = (LAS float*)(L + SS_VEC); LAS float* acum = dtv + 256; LAS float* ea = acum + 256; LAS float* wv = ea + 256; LAS float* rowsq = wv + 256; LAS float* wtot = rowsq + 256;
    const int tid = F.tid, lane = F.lane, w = F.wave, r = lane & 15, q = lane >> 4;
    const int g = e >> 3;
    const float dsk = F.d_skip[e];
    constexpr int NROW = T * NCH, NT = T / 16;
    float dtl = 0.f, sc = 0.f;
    if (tid < NROW) { dtl = F.misc[MS_DT + (size_t)(si.r0 + tid) * 16 + e]; sc = F.misc[MS_ACUM + (size_t)(si.r0 + tid) * 16 + e]; dtv[tid] = dtl; acum[tid] = sc; }
    if (lane == 63) wtot[w] = sc;
    bar_sync();
    if (tid < NROW) {
        if (MODE == 0) { float off = 0.f, tot = 0.f;
#pragma unroll
            for (int i = 0; i < NROW / 64; ++i) { const float x = wtot[i]; tot += x; if (i < w) off += x; }
            wv[tid] = __expf(tot - (sc + off)) * dtl;
            if (tid == 0) F.misc[MS_DEC + (size_t)sidx * 16 + e] = __expf(tot);
        } else { const float last = acum[tid | (T - 1)]; ea[tid] = __expf(sc); wv[tid] = __expf(last - sc) * dtl; }
    }
    f32x4 hst[4];
#pragma unroll
    for (int pt = 0; pt < 4; ++pt) {
        if (MODE == 0) hst[pt] = (f32x4){0.f, 0.f, 0.f, 0.f};
        else if (MODE == 1) { const bf16* S = (const bf16*)F.out + ST_SSD + (size_t)(sidx * 16 + e) * 8192;
#pragma unroll
            for (int j = 0; j < 4; ++j) hst[pt][j] = bf2f(S[(size_t)(16 * pt + r) * 128 + 16 * w + 4 * q + j]); }
        else { const float* S = F.st_ssm + (size_t)(sidx * 16 + e) * 8192;
#pragma unroll
            for (int j = 0; j < 4; ++j) hst[pt][j] = S[(size_t)(16 * pt + r) * 128 + 16 * w + 4 * q + j]; }
        if (MODE != 0) { unsigned long long pk = (unsigned long long)pk2(hst[pt][0], hst[pt][1]) | ((unsigned long long)pk2(hst[pt][2], hst[pt][3]) << 32);
            *(LAS unsigned long long*)(Hb + (16 * pt + r) * SP_A + 16 * w + 4 * q) = pk; }
    }
    bar_sync();
    for (int c = 0; c < NCH; ++c) {
        const int tb = c * T;
        for (int idx = tid; idx < T * 32; idx += NTHR) { const int t = idx >> 5, c2 = (idx & 31) * 2; float o0, o1; conv_pair(F, si, tb + t, 64 * e + c2, o0, o1);
            const float ww = wv[tb + t];
            if (MODE != 0) { Xt[c2 * SP_T + t] = (bf16)f2bf(o0); Xt[(c2 + 1) * SP_T + t] = (bf16)f2bf(o1); }
            Xw[c2 * SP_T + t] = (bf16)f2bf(o0 * ww); Xw[(c2 + 1) * SP_T + t] = (bf16)f2bf(o1 * ww); }
        for (int idx = tid; idx < T * 64; idx += NTHR) { const int t = idx >> 6, n = (idx & 63) * 2; float o0, o1; conv_pair(F, si, tb + t, 1024 + 128 * g + n, o0, o1);
            if (MODE != 0) *(LAS unsigned*)(Bm + t * SP_A + n) = pk2(o0, o1);
            Bt[n * SP_T + t] = (bf16)f2bf(o0); Bt[(n + 1) * SP_T + t] = (bf16)f2bf(o1); }
        if (MODE != 0) for (int idx = tid; idx < T * 64; idx += NTHR) { const int t = idx >> 6, n = (idx & 63) * 2; float o0, o1; conv_pair(F, si, tb + t, 1280 + 128 * g + n, o0, o1);
            *(LAS unsigned*)(Cm + t * SP_A + n) = pk2(o0, o1); }
        bar_sync();
        if (MODE != 0) {
            for (int ti = w; ti < NT * NT; ti += NWAVES) { const int lt = ti / NT, st = ti % NT;
                f32x4 acc = mma_tile(Cm + 16 * lt * SP_A, SP_A, Bm + 16 * st * SP_A, SP_A, 128, (f32x4){0.f, 0.f, 0.f, 0.f}, lane);
                const int s = 16 * st + r; const float as = acum[tb + s], ds = dtv[tb + s];
#pragma unroll
                for (int j = 0; j < 4; ++j) { const int l = 16 * lt + 4 * q + j; const float m = (l >= s) ? acc[j] * __expf(acum[tb + l] - as) * ds : 0.f; Mm[l * SP_T + s] = (bf16)f2bf(m); } }
            bar_sync();
            for (int ti = w; ti < NT * 4; ti += NWAVES) { const int lt = ti >> 2, pt = ti & 3;
                f32x4 acc = mma_tile(Cm + 16 * lt * SP_A, SP_A, Hb + 16 * pt * SP_A, SP_A, 128, (f32x4){0.f, 0.f, 0.f, 0.f}, lane);
#pragma unroll
                for (int j = 0; j < 4; ++j) acc[j] *= ea[tb + 16 * lt + 4 * q + j];
                acc = mma_tile(Mm + 16 * lt * SP_T, SP_T, Xt + 16 * pt * SP_T, SP_T, T, acc, lane);
#pragma unroll
                for (int j = 0; j < 4; ++j) { const int l = 16 * lt + 4 * q + j; Yt[l * 65 + 16 * pt + r] = acc[j] + dsk * bf2f(Xt[(16 * pt + r) * SP_T + l]); } }
            bar_sync();
            for (int idx = tid; idx < T * 32; idx += NTHR) { const int l = idx >> 5, pp = idx & 31;
                GAS unsigned* zp = (GAS unsigned*)(F.PROJ + (size_t)(si.r0 + tb + l) * LP + Z0 + 64 * e + 2 * pp); const unsigned zw = *zp;
                const float y0 = Yt[l * 65 + 2 * pp] * silu(bflo(zw)), y1 = Yt[l * 65 + 2 * pp + 1] * silu(bfhi(zw));
                float ss = y0 * y0 + y1 * y1;
#pragma unroll
                for (int o = 1; o < 32; o <<= 1) ss += __shfl_xor(ss, o);
                if ((lane & 31) == 0) rowsq[tb + l] = ss;
                *zp = pk2(y0, y1); }
        }
        const float dch = (MODE == 0) ? 1.f : __expf(acum[tb + T - 1]);
#pragma unroll
        for (int pt = 0; pt < 4; ++pt) { hst[pt] = hst[pt] * dch; hst[pt] = mma_tile(Bt + 16 * w * SP_T, SP_T, Xw + 16 * pt * SP_T, SP_T, T, hst[pt], lane);
            if (MODE != 0) { unsigned long long pk = (unsigned long long)pk2(hst[pt][0], hst[pt][1]) | ((unsigned long long)pk2(hst[pt][2], hst[pt][3]) << 32);
                *(LAS unsigned long long*)(Hb + (16 * pt + r) * SP_A + 16 * w + 4 * q) = pk; } }
        bar_sync();
    }
    if (MODE == 0) { float* S = F.out + ST_SSD + ((size_t)(sidx * 16 + e) * 128) * 64;
#pragma unroll
        for (int pt = 0; pt < 4; ++pt)
#pragma unroll
            for (int j = 0; j < 4; ++j) S[(size_t)(16 * w + 4 * q + j) * 64 + 16 * pt + r] = hst[pt][j]; }
    if (MODE != 0) { if (tid < NROW) F.misc[MS_SSQ + (size_t)(si.r0 + tid) * 16 + e] = rowsq[tid]; }
    if (MODE == 2) { float* S = F.out + O_SS + (size_t)(sidx * 16 + e) * 8192;
#pragma unroll
        for (int pt = 0; pt < 4; ++pt)
#pragma unroll
            for (int j = 0; j < 4; ++j) S[(size_t)(16 * pt + r) * 128 + 16 * w + 4 * q + j] = hst[pt][j]; }
    bar_sync();
}

constexpr int RS_QM = 0, RS_KM = RS_QM + 64 * SP_A * 2, RS_KW = RS_KM + 64 * SP_A * 2, RS_VT = RS_KW + 128 * SP_T * 2, RS_PM = RS_VT + 128 * SP_T * 2, RS_ST = RS_PM + 64 * SP_T * 2,
              RS_VEC = RS_ST + 128 * SP_A * 2, RS_END = RS_VEC + 2 * 64 * 4 * 4;
static_assert(RS_END <= RING_BYTES, "retention LDS map");
template <int T, int NCH, int MODE>
__device__ __forceinline__ void ret_unit(Frame& F, const SeqInfo si, const int hh, const int sidx) {
    LAS unsigned char* L = F.lds + RING_OFF;
    LAS bf16* Qm = (LAS bf16*)(L + RS_QM); LAS bf16* Km = (LAS bf16*)(L + RS_KM); LAS bf16* Yb = Km; LAS bf16* Kw = (LAS bf16*)(L + RS_KW); LAS bf16* Vt = (LAS bf16*)(L + RS_VT);
    LAS bf16* Pm = (LAS bf16*)(L + RS_PM); LAS bf16* St = (LAS bf16*)(L + RS_ST); LAS float* part = (LAS float*)(L + RS_VEC); LAS float* part2 = part + 256;
    const int tid = F.tid, lane = F.lane, w = F.wave, r = lane & 15, q = lane >> 4;
    constexpr int NROW = T * NCH, NT = T / 16, NSH = 8 / NT;
    const float lg2 = log2f(1.0f - exp2f(-5.0f - (float)hh));
    f32x4 sst[8];
#pragma unroll
    for (int i = 0; i < 8; ++i) {
        if (MODE == 0) sst[i] = (f32x4){0.f, 0.f, 0.f, 0.f};
        else { if (MODE == 1) { const bf16* S = (const bf16*)F.out + ST_RET + (size_t)(sidx * 8 + hh) * 16384;
#pragma unroll
                for (int j = 0; j < 4; ++j) sst[i][j] = bf2f(S[(size_t)(16 * i + r) * 128 + 16 * w + 4 * q + j]); }
            else { const float* S = F.st_ret + (size_t)(sidx * 8 + hh) * 16384;
#pragma unroll
                for (int j = 0; j < 4; ++j) sst[i][j] = S[(size_t)(16 * w + 4 * q + j) * 128 + 16 * i + r]; }
            unsigned long long pk = (unsigned long long)pk2(sst[i][0], sst[i][1]) | ((unsigned long long)pk2(sst[i][2], sst[i][3]) << 32);
            *(LAS unsigned long long*)(St + (16 * i + r) * SP_A + 16 * w + 4 * q) = pk; }
    }
    for (int c = 0; c < NCH; ++c) {
        const int tb = c * T;
        for (int idx = tid; idx < T * 64; idx += NTHR) { const int t = idx >> 6, j2 = (idx & 63) * 2;
            const GAS bf16* row = (const GAS bf16*)(F.PROJ + (size_t)(si.r0 + tb + t) * LP);
            const unsigned kw2 = *(const GAS unsigned*)(row + K0 + 128 * hh + j2);
            const float kwt = exp2f(lg2 * (float)((MODE == 0 ? NROW - 1 - tb : T - 1) - t));
            Kw[j2 * SP_T + t] = (bf16)f2bf(bflo(kw2) * kwt); Kw[(j2 + 1) * SP_T + t] = (bf16)f2bf(bfhi(kw2) * kwt);
            if (MODE != 0) { *(LAS unsigned*)(Qm + t * SP_A + j2) = *(const GAS unsigned*)(row + Q0 + 128 * hh + j2); *(LAS unsigned*)(Km + t * SP_A + j2) = kw2; } }
        for (int idx = tid; idx < T * 64; idx += NTHR) { const int t = idx >> 6, e2 = (idx & 63) * 2;
            const unsigned vw = *(const GAS unsigned*)(F.PROJ + (size_t)(si.r0 + tb + t) * LP + V0 + 128 * hh + e2);
            Vt[e2 * SP_T + t] = (bf16)(vw & 0xffffu); Vt[(e2 + 1) * SP_T + t] = (bf16)(vw >> 16); }
        bar_sync();
        if (MODE != 0) {
            for (int ti = w; ti < NT * NT; ti += NWAVES) { const int lt = ti / NT, st = ti % NT;
                f32x4 acc = mma_tile(Qm + 16 * lt * SP_A, SP_A, Km + 16 * st * SP_A, SP_A, 128, (f32x4){0.f, 0.f, 0.f, 0.f}, lane);
                const int s = 16 * st + r;
#pragma unroll
                for (int j = 0; j < 4; ++j) { const int l = 16 * lt + 4 * q + j; const float m = (l >= s) ? acc[j] * exp2f(lg2 * (float)(l - s)) : 0.f; Pm[l * SP_T + s] = (bf16)f2bf(m); } }
            bar_sync();
            const int lt = w % NT, slot = w / NT;
            f32x4 acc[NT];
#pragma unroll
            for (int i = 0; i < NT; ++i) { const int et = slot * NT + i;
                acc[i] = mma_tile(Qm + 16 * lt * SP_A, SP_A, St + 16 * et * SP_A, SP_A, 128, (f32x4){0.f, 0.f, 0.f, 0.f}, lane);
#pragma unroll
                for (int j = 0; j < 4; ++j) acc[i][j] *= exp2f(lg2 * (float)(16 * lt + 4 * q + j + 1));
                acc[i] = mma_tile(Pm + 16 * lt * SP_T, SP_T, Vt + 16 * et * SP_T, SP_T, T, acc[i], lane); }
            float mean[4], rstd[4];
#pragma unroll
            for (int j = 0; j < 4; ++j) { float s = 0.f;
#pragma unroll
                for (int i = 0; i < NT; ++i) s += acc[i][j];
                s += __shfl_xor(s, 1); s += __shfl_xor(s, 2); s += __shfl_xor(s, 4); s += __shfl_xor(s, 8);
                if (r == 0) part[(16 * lt + 4 * q + j) * 4 + slot] = s; }
            bar_sync();
#pragma unroll
            for (int j = 0; j < 4; ++j) { float s = 0.f;
#pragma unroll
                for (int k = 0; k < NSH; ++k) s += part[(16 * lt + 4 * q + j) * 4 + k];
                mean[j] = s * (1.0f / 128.0f); float d2 = 0.f;
#pragma unroll
                for (int i = 0; i < NT; ++i) { const float d = acc[i][j] - mean[j]; d2 += d * d; }
                d2 += __shfl_xor(d2, 1); d2 += __shfl_xor(d2, 2); d2 += __shfl_xor(d2, 4); d2 += __shfl_xor(d2, 8);
                if (r == 0) part2[(16 * lt + 4 * q + j) * 4 + slot] = d2; }
            bar_sync();
#pragma unroll
            for (int j = 0; j < 4; ++j) { float s = 0.f;
#pragma unroll
                for (int k = 0; k < NSH; ++k) s += part2[(16 * lt + 4 * q + j) * 4 + k];
                rstd[j] = 1.0f / sqrtf(s * (1.0f / 128.0f) + EPS); }
#pragma unroll
            for (int i = 0; i < NT; ++i)
#pragma unroll
                for (int j = 0; j < 4; ++j) Yb[(16 * lt + 4 * q + j) * SP_A + 16 * (slot * NT + i) + r] = (bf16)f2bf((acc[i][j] - mean[j]) * rstd[j]);
            bar_sync();
            for (int idx = tid; idx < T * 16; idx += NTHR) { const int l = idx >> 4, ch = idx & 15;
                const v4u yv = *(const LAS v4u*)(Yb + l * SP_A + 8 * ch);
                GAS v4u* gp = (GAS v4u*)(F.PROJ + (size_t)(si.r0 + tb + l) * LP + G0 + 128 * hh + 8 * ch); const v4u gv = *gp;
                v4u o;
#pragma unroll
                for (int k = 0; k < 4; ++k) o[k] = pk2(bflo(yv[k]) * silu(bflo(gv[k])), bfhi(yv[k]) * silu(bfhi(gv[k])));
                *gp = o; }
        }
        const float dch = (MODE == 0) ? 1.f : exp2f(lg2 * (float)T);
#pragma unroll
        for (int i = 0; i < 8; ++i) { sst[i] = sst[i] * dch; sst[i] = mma_tile(Kw + 16 * w * SP_T, SP_T, Vt + 16 * i * SP_T, SP_T, T, sst[i], lane);
            if (MODE != 0) { unsigned long long pk = (unsigned long long)pk2(sst[i][0], sst[i][1]) | ((unsigned long long)pk2(sst[i][2], sst[i][3]) << 32);
                *(LAS unsigned long long*)(St + (16 * i + r) * SP_A + 16 * w + 4 * q) = pk; } }
        bar_sync();
    }
    if (MODE == 0) { bf16* S = (bf16*)F.out + ST_RET + (size_t)(sidx * 8 + hh) * 16384;
#pragma unroll
        for (int i = 0; i < 8; ++i) *(GAS unsigned long long*)(S + (size_t)(16 * i + r) * 128 + 16 * w + 4 * q) = (unsigned long long)pk2(sst[i][0], sst[i][1]) | ((unsigned long long)pk2(sst[i][2], sst[i][3]) << 32); }
    if (MODE == 2) { float* S = F.out + O_RS + (size_t)(sidx * 8 + hh) * 16384;
#pragma unroll
        for (int i = 0; i < 8; ++i)
#pragma unroll
            for (int j = 0; j < 4; ++j) S[(size_t)(16 * w + 4 * q + j) * 128 + 16 * i + r] = sst[i][j]; }
    bar_sync();
}


__device__ __forceinline__ void conv_walk(const Frame& F, int row_first, int nrows, int col, float (&hal)[3][8], float* ncv) {
    float wk[4][8], bs[8];
#pragma unroll
    for (int k = 0; k < 4; ++k) { const f32x4 a = *(const GAS f32x4*)(F.conv_w + k * CONVD + col), b = *(const GAS f32x4*)(F.conv_w + k * CONVD + col + 4);
#pragma unroll
        for (int i = 0; i < 4; ++i) { wk[k][i] = a[i]; wk[k][4 + i] = b[i]; } }
    { const f32x4 a = *(const GAS f32x4*)(F.conv_b + col), b = *(const GAS f32x4*)(F.conv_b + col + 4);
#pragma unroll
      for (int i = 0; i < 4; ++i) { bs[i] = a[i]; bs[4 + i] = b[i]; } }
    GAS bf16* p = (GAS bf16*)(F.PROJ + (size_t)row_first * LP + XBC0 + col);
    v4u rw[8], rn[8];
#pragma unroll
    for (int u = 0; u < 8; ++u) rw[u] = *(const GAS v4u*)(p + (size_t)u * LP);
    for (int t0 = 0; t0 < nrows; t0 += 8) {
        if (t0 + 8 < nrows) {
#pragma unroll
            for (int u = 0; u < 8; ++u) rn[u] = *(const GAS v4u*)(p + (size_t)(t0 + 8 + u) * LP); }
        __builtin_amdgcn_sched_barrier(0);
#pragma unroll
        for (int u = 0; u < 8; ++u) { const int t = t0 + u; float x[8];
#pragma unroll
            for (int i = 0; i < 4; ++i) { x[2 * i] = bflo(rw[u][i]); x[2 * i + 1] = bfhi(rw[u][i]); }
            float y[8];
#pragma unroll
            for (int i = 0; i < 8; ++i) { const float a = bs[i] + hal[0][i] * wk[0][i] + hal[1][i] * wk[1][i] + hal[2][i] * wk[2][i] + x[i] * wk[3][i]; y[i] = silu(a);
                hal[0][i] = hal[1][i]; hal[1][i] = hal[2][i]; hal[2][i] = x[i]; }
            v4u o;
#pragma unroll
            for (int i = 0; i < 4; ++i) o[i] = pk2(y[2 * i], y[2 * i + 1]);
            *(GAS v4u*)(p + (size_t)t * LP) = o;
            if (ncv != nullptr && t >= nrows - 3) { float* q = ncv + (size_t)(t - (nrows - 3)) * CONVD;
#pragma unroll
                for (int i = 0; i < 8; ++i) q[i] = x[i]; } }
#pragma unroll
        for (int u = 0; u < 8; ++u) rw[u] = rn[u];
    }
}
__device__ __forceinline__ int half_col(int g, int cg) { return cg < 64 ? 512 * g + 8 * cg : (cg < 80 ? 1024 + 128 * g + 8 * (cg - 64) : 1280 + 128 * g + 8 * (cg - 80)); }
__device__ __forceinline__ void conv_unit(Frame& F, const int u) {
    const int tid = F.tid, lane = F.lane, w = F.wave;
    {
        const int pm = u >> 1, g = u & 1, r0 = pm * 256;
        if (pm < NPP) {
            const int sl = tid / 96, cg = tid % 96; float hal[3][8]; const bool act = tid < 384; const int col = half_col(g, cg);
            if (act) {
                const bool seq0 = (pm & 63) == 0 && sl == 0;
                const GAS bf16* src = (sl > 0) ? (const GAS bf16*)(F.PROJ + (size_t)(r0 + 64 * sl - 3) * LP + XBC0 + col) : (const GAS bf16*)(F.halo + (size_t)((pm - 1) * 3) * CONVD + col);
                const int pitch = (sl > 0) ? LP : CONVD;
#pragma unroll
                for (int j = 0; j < 3; ++j) { v4u rw = (v4u){0u, 0u, 0u, 0u}; if (!seq0) rw = *(const GAS v4u*)(src + (size_t)j * pitch);
#pragma unroll
                    for (int i = 0; i < 4; ++i) { hal[j][2 * i] = bflo(rw[i]); hal[j][2 * i + 1] = bfhi(rw[i]); } }
            }
            const int chunk = w & 3, hq = w >> 2;
            float dr[4];
#pragma unroll
            for (int i = 0; i < 4; ++i) dr[i] = bf2f(*(const GAS bf16*)(F.PROJ + (size_t)(r0 + 64 * chunk + lane) * LP + DT0 + 8 * g + 4 * hq + i));
            bar_sync();
            if (act) conv_walk(F, r0 + 64 * sl, 64, col, hal, nullptr);
#pragma unroll
            for (int i = 0; i < 4; ++i) { const int e = 8 * g + 4 * hq + i; const float dt = softplus_f(dr[i] + F.dt_bias[e]); float sc = dt * -__expf(F.a_log[e]);
#pragma unroll
                for (int o = 1; o < 64; o <<= 1) { const float v = __shfl_up(sc, o); if (lane >= o) sc += v; }
                const size_t ix = (size_t)(r0 + 64 * chunk + lane) * 16 + e; F.misc[MS_DT + ix] = dt; F.misc[MS_ACUM + ix] = sc; }
        } else {
            for (int it = tid; it < 8 * 96; it += NTHR) { const int sq = it / 96, cg = it % 96, col = half_col(g, cg), sb = (pm - NPP) * 8 + sq; float hal[3][8];
#pragma unroll
                for (int j = 0; j < 3; ++j) { const f32x4 a = *(const GAS f32x4*)(F.st_conv + (size_t)(sb * 3 + j) * CONVD + col), b = *(const GAS f32x4*)(F.st_conv + (size_t)(sb * 3 + j) * CONVD + col + 4);
#pragma unroll
                    for (int i = 0; i < 4; ++i) { hal[j][i] = a[i]; hal[j][4 + i] = b[i]; } }
                conv_walk(F, r0 + 32 * sq, 32, col, hal, F.out + O_CS + (size_t)(sb * 3) * CONVD + col); }
            const int chunk = w & 3, hq = w >> 2;
#pragma unroll
            for (int i = 0; i < 4; ++i) { const int e = 8 * g + 4 * hq + i; const size_t row = (size_t)(r0 + 64 * chunk + lane);
                const float dt = softplus_f(bf2f(*(const GAS bf16*)(F.PROJ + row * LP + DT0 + e)) + F.dt_bias[e]); float sc = dt * -__expf(F.a_log[e]);
#pragma unroll
                for (int o = 1; o < 32; o <<= 1) { const float v = __shfl_up(sc, o); if ((lane & 31) >= o) sc += v; }
                F.misc[MS_DT + row * 16 + e] = dt; F.misc[MS_ACUM + row * 16 + e] = sc; }
        }
        bar_sync();
    }
}

typedef short v4i16_t __attribute__((ext_vector_type(4)));
typedef unsigned u32x4v __attribute__((ext_vector_type(4)));
constexpr int PK = 272, PX = 144;
__device__ __forceinline__ v4i16_t lds_tr(const LAS unsigned char* p) { return __builtin_amdgcn_ds_read_tr16_b64_v4i16((LAS v4i16_t*)p); }
__device__ __forceinline__ bf16x8 frag_row(const LAS unsigned char* img, int pitch, int i0, int k0, int lane) { return *(const LAS bf16x8*)(img + (i0 + (lane & 15)) * pitch + (k0 + 8 * (lane >> 4)) * 2); }
__device__ __forceinline__ bf16x8 frag_tr(const LAS unsigned char* img, int pitch, int k0, int i0, int lane) {
    const int g = lane >> 4, q = (lane & 15) >> 2, pp = lane & 3; const LAS unsigned char* a = img + (k0 + 8 * g + q) * pitch + i0 * 2 + 8 * pp;
    const v4i16_t lo = lds_tr(a), hi = lds_tr(a + 4 * pitch); return __builtin_shufflevector(lo, hi, 0, 1, 2, 3, 4, 5, 6, 7);
}
__device__ __forceinline__ bf16x8 frag_tr_perm(const LAS unsigned char* img, int pitch, int k0, int i0, int lane) {
    const int g = lane >> 4, q = (lane & 15) >> 2, pp = lane & 3; const LAS unsigned char* a = img + (k0 + 4 * g + q) * pitch + i0 * 2 + 8 * pp;
    const v4i16_t lo = lds_tr(a), hi = lds_tr(a + 16 * pitch); return __builtin_shufflevector(lo, hi, 0, 1, 2, 3, 4, 5, 6, 7);
}
#define MFMA16(a, b, c) __builtin_amdgcn_mfma_f32_16x16x32_bf16((a), (b), (c), 0, 0, 0)
__device__ __forceinline__ void stage128(LAS unsigned char* img, const bf16* src, int tid) {
#pragma unroll
    for (int i = 0; i < 8; ++i) { const int id = tid + NTHR * i, row = id >> 4, ch = id & 15; *(LAS v4u*)(img + row * PK + 16 * ch) = *(const GAS v4u*)(src + (size_t)row * LP + 8 * ch); }
}
__device__ __forceinline__ void stage128_swz(LAS unsigned char* img, const bf16* src, int tid) {
#pragma unroll
    for (int i = 0; i < 8; ++i) { const int id = tid + NTHR * i, row = id >> 4, ch = id & 15; *(LAS v4u*)(img + row * 256 + 16 * (ch ^ (row & 7))) = *(const GAS v4u*)(src + (size_t)row * LP + 8 * ch); }
}
__device__ __forceinline__ bf16x8 frag_row_swz(const LAS unsigned char* img, int i0, int k0, int lane) { const int row = i0 + (lane & 15), ch = (k0 >> 3) + (lane >> 4); return *(const LAS bf16x8*)(img + row * 256 + 16 * (ch ^ (row & 7))); }
constexpr int NA_B = 0, NA_X = 256 * PK, NA_END = NA_X + 2 * 256 * PX;
static_assert(NA_END <= SCAN_LDS, "ssd local-state LDS map");
__device__ __forceinline__ void ssd_local_unit(Frame& F, const int gp, const int g) {
    LAS unsigned char* L = F.lds;
    int tid = F.tid; asm volatile("" : "+v"(tid)); const int lane = tid & 63, w = F.wave, r0 = gp * 256;
    stage128(L + NA_B, F.PROJ + (size_t)r0 * LP + XB0 + 128 * g, tid); __builtin_amdgcn_sched_barrier(0);
    const int srow = tid >> 3, sch = tid & 7;
    auto load_head = [&](int e, v4u (&xr)[4], float (&ww)[4]) { const float* AC = F.misc + MS_ACUM + (size_t)r0 * 16 + e; const float* DT = F.misc + MS_DT + (size_t)r0 * 16 + e;
        float tot[4];
#pragma unroll
        for (int i = 0; i < 4; ++i) tot[i] = AC[(size_t)(64 * i + 63) * 16];
        const float atot = (tot[0] + tot[1]) + (tot[2] + tot[3]); float off = 0.f;
#pragma unroll
        for (int i = 0; i < 4; ++i) { const int row = srow + 64 * i; xr[i] = *(const GAS v4u*)(F.PROJ + (size_t)(r0 + row) * LP + XBC0 + 64 * e + 8 * sch);
            ww[i] = __expf(atot - (AC[(size_t)row * 16] + off)) * DT[(size_t)row * 16]; off += tot[i]; }
        if (tid == 0) F.misc[MS_DEC + (size_t)gp * 16 + e] = __expf(atot); };
    auto park_head = [&](int buf, const v4u (&xr)[4], const float (&ww)[4]) {
#pragma unroll
        for (int i = 0; i < 4; ++i) { v4u o;
#pragma unroll
            for (int k = 0; k < 4; ++k) o[k] = pkh(bflo(xr[i][k]) * ww[i], bfhi(xr[i][k]) * ww[i]);
            *(LAS v4u*)(L + NA_X + buf * 256 * PX + (srow + 64 * i) * PX + 16 * sch) = o; } };
    { v4u xr[4]; float ww[4]; load_head(8 * g, xr, ww); park_head(0, xr, ww); }
    bar_sync();
    for (int e8 = 0; e8 < 8; ++e8) { const int e = 8 * g + e8, buf = e8 & 1; const LAS unsigned char* XI = L + NA_X + buf * 256 * PX;
        v4u xr[4]; float ww[4];
        if (e8 < 7) load_head(e + 1, xr, ww);
        f32x4 acc[4];
#pragma unroll
        for (int pt = 0; pt < 4; ++pt) acc[pt] = (f32x4){0.f, 0.f, 0.f, 0.f};
#pragma unroll
        for (int ks = 0; ks < 8; ks += 2) { bf16x8 a[2], b[2][4];
#pragma unroll
            for (int k2 = 0; k2 < 2; ++k2) { a[k2] = frag_tr(L + NA_B, PK, 32 * (ks + k2), 16 * w, lane);
#pragma unroll
                for (int pt = 0; pt < 4; ++pt) b[k2][pt] = frag_tr(XI, PX, 32 * (ks + k2), 16 * pt, lane); }
            __builtin_amdgcn_sched_barrier(0);
#pragma unroll
            for (int k2 = 0; k2 < 2; ++k2)
#pragma unroll
                for (int pt = 0; pt < 4; ++pt) acc[pt] = MFMA16(a[k2], b[k2][pt], acc[pt]);
            __builtin_amdgcn_sched_barrier(0); }
        bf16* S = (bf16*)F.out + ST_SSD + (size_t)(gp * 16 + e) * 8192;
#pragma unroll
        for (int pt = 0; pt < 4; ++pt) *(GAS unsigned long long*)(S + (size_t)(16 * pt + (lane & 15)) * 128 + 16 * w + 4 * (lane >> 4)) = (unsigned long long)pkh(acc[pt][0], acc[pt][1]) | ((unsigned long long)pkh(acc[pt][2], acc[pt][3]) << 32);
        if (e8 < 7) park_head(buf ^ 1, xr, ww);
        lds_barrier();
    }
    bar_sync();
}
constexpr int NC_K = 0, NC_V = 256 * PK;
static_assert(NC_V + 256 * PK <= SCAN_LDS, "retention LDS map");
__device__ __forceinline__ void ret_local_units(Frame& F) {
    LAS unsigned char* L = F.lds; int tid = F.tid; asm volatile("" : "+v"(tid)); const int lane = tid & 63, w = F.wave;
    constexpr int NU_RET_P = NPP * RH; int u = F.vcu; if (u >= NU_RET_P) return;
    { const int gp = u >> 3, hh = u & 7; stage128(L + NC_K, F.PROJ + (size_t)gp * 256 * LP + K0 + 128 * hh, tid); stage128(L + NC_V, F.PROJ + (size_t)gp * 256 * LP + V0 + 128 * hh, tid); }
    bar_sync();
    for (;;) { const int gp = u >> 3, hh = u & 7, un = u + F.G; const bool more = un < NU_RET_P;
        v4u kr[8], vr[8];
        if (more) { const bf16* kp = F.PROJ + (size_t)(un >> 3) * 256 * LP + K0 + 128 * (un & 7); const bf16* vp = F.PROJ + (size_t)(un >> 3) * 256 * LP + V0 + 128 * (un & 7);
#pragma unroll
            for (int i = 0; i < 8; ++i) { const int id = tid + NTHR * i, row = id >> 4, ch = id & 15; kr[i] = *(const GAS v4u*)(kp + (size_t)row * LP + 8 * ch); vr[i] = *(const GAS v4u*)(vp + (size_t)row * LP + 8 * ch); } }
        f32x4 acc[8];
#pragma unroll
        for (int et = 0; et < 8; ++et) acc[et] = (f32x4){0.f, 0.f, 0.f, 0.f};
#pragma unroll 2
        for (int ks = 0; ks < 8; ++ks) { const bf16x8 a = frag_tr(L + NC_K, PK, 32 * ks, 16 * w, lane); bf16x8 b[8];
#pragma unroll
            for (int et = 0; et < 8; ++et) b[et] = frag_tr(L + NC_V, PK, 32 * ks, 16 * et, lane);
            __builtin_amdgcn_sched_barrier(0);
#pragma unroll
            for (int et = 0; et < 8; ++et) acc[et] = MFMA16(a, b[et], acc[et]);
            __builtin_amdgcn_sched_barrier(0); }
        const float sc = exp2f(255.0f * log2f(1.0f - exp2f(-5.0f - (float)hh)));
        bf16* S = (bf16*)F.out + ST_RET + (size_t)(gp * 8 + hh) * 16384;
#pragma unroll
        for (int et = 0; et < 8; ++et) *(GAS unsigned long long*)(S + (size_t)(16 * et + (lane & 15)) * 128 + 16 * w + 4 * (lane >> 4)) =
            (unsigned long long)pkh(acc[et][0] * sc, acc[et][1] * sc) | ((unsigned long long)pkh(acc[et][2] * sc, acc[et][3] * sc) << 32);
        if (!more) break;
        lds_barrier();
#pragma unroll
        for (int i = 0; i < 8; ++i) { const int id = tid + NTHR * i, row = id >> 4, ch = id & 15; *(LAS v4u*)(L + NC_K + row * PK + 16 * ch) = kr[i]; *(LAS v4u*)(L + NC_V + row * PK + 16 * ch) = vr[i]; }
        lds_barrier();
        u = un;
    }
    bar_sync();
}
__device__ __forceinline__ void ret_out_unit(Frame& F, const int gp, const int hh) {
    LAS unsigned char* L = F.lds; int tid = F.tid; asm volatile("" : "+v"(tid));
    const int lane = tid & 63, w = F.wave, r0 = gp * 256, g = lane >> 4, r = lane & 15;
    stage128(L + NC_K, F.PROJ + (size_t)r0 * LP + K0 + 128 * hh, tid); __builtin_amdgcn_sched_barrier(0); stage128(L + NC_V, F.PROJ + (size_t)r0 * LP + V0 + 128 * hh, tid); __builtin_amdgcn_sched_barrier(0);
    bf16x8 qf[2][4];
#pragma unroll
    for (int lt = 0; lt < 2; ++lt)
#pragma unroll
        for (int ks = 0; ks < 4; ++ks) qf[lt][ks] = *(const GAS bf16x8*)(F.PROJ + (size_t)(r0 + 32 * w + 16 * lt + r) * LP + Q0 + 128 * hh + 32 * ks + 8 * g);
    const float gam = 1.0f - exp2f(-5.0f - (float)hh);
    f32x4 acc[8][2];
    { const bf16* S = (const bf16*)F.out + ST_RET + (size_t)(gp * 8 + hh) * 16384;
#pragma unroll
      for (int eh = 0; eh < 2; ++eh) { bf16x8 a[4][4];
#pragma unroll
          for (int e4 = 0; e4 < 4; ++e4)
#pragma unroll
              for (int ks = 0; ks < 4; ++ks) a[e4][ks] = *(const GAS bf16x8*)(S + (size_t)(16 * (4 * eh + e4) + r) * 128 + 32 * ks + 8 * g);
          __builtin_amdgcn_sched_barrier(0);
#pragma unroll
          for (int e4 = 0; e4 < 4; ++e4) { const int et = 4 * eh + e4; acc[et][0] = (f32x4){0.f, 0.f, 0.f, 0.f}; acc[et][1] = (f32x4){0.f, 0.f, 0.f, 0.f};
#pragma unroll
              for (int ks = 0; ks < 4; ++ks) { acc[et][0] = MFMA16(a[e4][ks], qf[0][ks], acc[et][0]); acc[et][1] = MFMA16(a[e4][ks], qf[1][ks], acc[et][1]); }
              acc[et][0] = acc[et][0] * gam; acc[et][1] = acc[et][1] * gam; }
          __builtin_amdgcn_sched_barrier(0); } }
    bar_sync();
    unsigned long long gpre[2][8];
#pragma unroll
    for (int lt = 0; lt < 2; ++lt)
#pragma unroll
        for (int et = 0; et < 8; ++et) gpre[lt][et] = *(const GAS unsigned long long*)(F.PROJ + (size_t)(r0 + 32 * w + 16 * lt + r) * LP + G0 + 128 * hh + 4 * g + 16 * et);
    for (int sb = 0; sb <= w; ++sb) {
        f32x4 pt[2][2];
#pragma unroll
        for (int st = 0; st < 2; ++st) { pt[st][0] = (f32x4){0.f, 0.f, 0.f, 0.f}; pt[st][1] = (f32x4){0.f, 0.f, 0.f, 0.f}; }
        bf16x8 af[4][2];
#pragma unroll
        for (int ks = 0; ks < 4; ++ks)
#pragma unroll
            for (int st = 0; st < 2; ++st) af[ks][st] = frag_row(L + NC_K, PK, 32 * sb + 16 * st, 32 * ks, lane);
        __builtin_amdgcn_sched_barrier(0);
#pragma unroll
        for (int ks = 0; ks < 4; ++ks)
#pragma unroll
            for (int st = 0; st < 2; ++st) { pt[st][0] = MFMA16(af[ks][st], qf[0][ks], pt[st][0]); pt[st][1] = MFMA16(af[ks][st], qf[1][ks], pt[st][1]); }
        __builtin_amdgcn_sched_barrier(0);
        bf16x8 vf[8];
#pragma unroll
        for (int et = 0; et < 8; ++et) vf[et] = frag_tr_perm(L + NC_V, PK, 32 * sb, 16 * et, lane);
        __builtin_amdgcn_sched_barrier(0);
        if (sb == w) {
#pragma unroll
            for (int st = 0; st < 2; ++st)
#pragma unroll
                for (int lt = 0; lt < 2; ++lt)
#pragma unroll
                    for (int j = 0; j < 4; ++j) if (16 * st + 4 * g + j > 16 * lt + r) pt[st][lt][j] = 0.f;
        }
        bf16x8 pf[2];
#pragma unroll
        for (int lt = 0; lt < 2; ++lt) { u32x4v pw; pw[0] = pkh(pt[0][lt][0], pt[0][lt][1]); pw[1] = pkh(pt[0][lt][2], pt[0][lt][3]); pw[2] = pkh(pt[1][lt][0], pt[1][lt][1]); pw[3] = pkh(pt[1][lt][2], pt[1][lt][3]);
            pf[lt] = __builtin_bit_cast(bf16x8, pw); }
#pragma unroll
        for (int et = 0; et < 8; ++et) { acc[et][0] = MFMA16(vf[et], pf[0], acc[et][0]); acc[et][1] = MFMA16(vf[et], pf[1], acc[et][1]); }
    }
#pragma unroll
    for (int lt = 0; lt < 2; ++lt) {
        float sm = 0.f;
#pragma unroll
        for (int et = 0; et < 8; ++et) sm += (acc[et][lt][0] + acc[et][lt][1]) + (acc[et][lt][2] + acc[et][lt][3]);
        sm += __shfl_xor(sm, 16); sm += __shfl_xor(sm, 32);
        const float mean = sm * (1.0f / 128.0f); float d2 = 0.f;
#pragma unroll
        for (int et = 0; et < 8; ++et)
#pragma unroll
            for (int j = 0; j < 4; ++j) { const float d = acc[et][lt][j] - mean; d2 += d * d; }
        d2 += __shfl_xor(d2, 16); d2 += __shfl_xor(d2, 32);
        const float rstd = 1.0f / sqrtf(d2 * (1.0f / 128.0f) + EPS);
        bf16* grow = F.PROJ + (size_t)(r0 + 32 * w + 16 * lt + r) * LP + G0 + 128 * hh + 4 * g;
#pragma unroll
        for (int et = 0; et < 8; ++et) { GAS unsigned long long* gp8 = (GAS unsigned long long*)(grow + 16 * et); const unsigned long long gv = gpre[lt][et]; const unsigned g0 = (unsigned)gv, g1 = (unsigned)(gv >> 32);
            const float y0 = (acc[et][lt][0] - mean) * rstd * silu(bflo(g0)), y1 = (acc[et][lt][1] - mean) * rstd * silu(bfhi(g0)), y2 = (acc[et][lt][2] - mean) * rstd * silu(bflo(g1)), y3 = (acc[et][lt][3] - mean) * rstd * silu(bfhi(g1));
            *gp8 = (unsigned long long)pkh(y0, y1) | ((unsigned long long)pkh(y2, y3) << 32); }
    }
    bar_sync();
}

constexpr int ND_B = 0, ND_X = 256 * PK, ND_A = ND_X + 256 * PX, ND_D = ND_A + 256 * 4, ND_END = ND_D + 256 * 4;
static_assert(ND_END <= SCAN_LDS, "ssd output LDS map");
__device__ __forceinline__ void ssd_out_unit(Frame& F, const int gp, const int e) {
    LAS unsigned char* L = F.lds; LAS float* acP = (LAS float*)(L + ND_A); LAS float* dtv = (LAS float*)(L + ND_D);
    const int tid = F.tid, lane = F.lane, w = F.wave, r0 = gp * 256, g = e >> 3, gq = lane >> 4, r = lane & 15;
    stage128(L + ND_B, F.PROJ + (size_t)r0 * LP + XB0 + 128 * g, tid); __builtin_amdgcn_sched_barrier(0);
#pragma unroll
    for (int i = 0; i < 4; ++i) { const int id = tid + NTHR * i, row = id >> 3, ch = id & 7; *(LAS v4u*)(L + ND_X + row * PX + 16 * ch) = *(const GAS v4u*)(F.PROJ + (size_t)(r0 + row) * LP + XBC0 + 64 * e + 8 * ch); }
    if (tid < 256) { const float* AC = F.misc + MS_ACUM + (size_t)r0 * 16 + e; float off = 0.f;
#pragma unroll
        for (int i = 0; i < 3; ++i) { const float x = AC[(size_t)(64 * i + 63) * 16]; if (i < (tid >> 6)) off += x; }
        acP[tid] = AC[(size_t)tid * 16] + off; dtv[tid] = F.misc[MS_DT + (size_t)(r0 + tid) * 16 + e]; }
    __builtin_amdgcn_sched_barrier(0);
    bf16x8 cf[2][4];
#pragma unroll
    for (int lt = 0; lt < 2; ++lt)
#pragma unroll
        for (int ks = 0; ks < 4; ++ks) cf[lt][ks] = *(const GAS bf16x8*)(F.PROJ + (size_t)(r0 + 32 * w + 16 * lt + r) * LP + XC0 + 128 * g + 32 * ks + 8 * gq);
    f32x4 acc[4][2];
    { const bf16* S = (const bf16*)F.out + ST_SSD + (size_t)(gp * 16 + e) * 8192;
#pragma unroll
      for (int pt = 0; pt < 4; ++pt) { acc[pt][0] = (f32x4){0.f, 0.f, 0.f, 0.f}; acc[pt][1] = (f32x4){0.f, 0.f, 0.f, 0.f};
#pragma unroll
          for (int ks = 0; ks < 4; ++ks) { const bf16x8 a = *(const GAS bf16x8*)(S + (size_t)(16 * pt + r) * 128 + 32 * ks + 8 * gq);
              acc[pt][0] = MFMA16(a, cf[0][ks], acc[pt][0]); acc[pt][1] = MFMA16(a, cf[1][ks], acc[pt][1]); }
          __builtin_amdgcn_sched_barrier(0); } }
    bar_sync();
    float al[2];
#pragma unroll
    for (int lt = 0; lt < 2; ++lt) { al[lt] = acP[32 * w + 16 * lt + r]; const float ex = __expf(al[lt]);
#pragma unroll
        for (int pt = 0; pt < 4; ++pt) acc[pt][lt] = acc[pt][lt] * ex; }
    const float dsk = F.d_skip[e];
    for (int sb = 0; sb <= w; ++sb) {
        f32x4 pt2[2][2];
#pragma unroll
        for (int st = 0; st < 2; ++st) { pt2[st][0] = (f32x4){0.f, 0.f, 0.f, 0.f}; pt2[st][1] = (f32x4){0.f, 0.f, 0.f, 0.f}; }
#pragma unroll
        for (int ks = 0; ks < 4; ++ks)
#pragma unroll
            for (int st = 0; st < 2; ++st) { const bf16x8 a = frag_row(L + ND_B, PK, 32 * sb + 16 * st, 32 * ks, lane);
                pt2[st][0] = MFMA16(a, cf[0][ks], pt2[st][0]); pt2[st][1] = MFMA16(a, cf[1][ks], pt2[st][1]); }
        const bool diag = (sb == w);
#pragma unroll
        for (int st = 0; st < 2; ++st) { const f32x4 as = *(const LAS f32x4*)(acP + 32 * sb + 16 * st + 4 * gq), ds = *(const LAS f32x4*)(dtv + 32 * sb + 16 * st + 4 * gq);
#pragma unroll
            for (int lt = 0; lt < 2; ++lt)
#pragma unroll
                for (int j = 0; j < 4; ++j) { float m = pt2[st][lt][j] * __expf(al[lt] - as[j]) * ds[j];
                    if (diag) { const int sr = 16 * st + 4 * gq + j, lr = 16 * lt + r; if (sr > lr) m = 0.f; if (sr == lr) m += dsk; }
                    pt2[st][lt][j] = m; } }
        bf16x8 pf[2];
#pragma unroll
        for (int lt = 0; lt < 2; ++lt) { u32x4v pw; pw[0] = pk2(pt2[0][lt][0], pt2[0][lt][1]); pw[1] = pk2(pt2[0][lt][2], pt2[0][lt][3]); pw[2] = pk2(pt2[1][lt][0], pt2[1][lt][1]); pw[3] = pk2(pt2[1][lt][2], pt2[1][lt][3]);
            pf[lt] = __builtin_bit_cast(bf16x8, pw); }
#pragma unroll
        for (int pt = 0; pt < 4; ++pt) { const bf16x8 a = frag_tr_perm(L + ND_X, PX, 32 * sb, 16 * pt, lane);
            acc[pt][0] = MFMA16(a, pf[0], acc[pt][0]); acc[pt][1] = MFMA16(a, pf[1], acc[pt][1]); }
    }
#pragma unroll
    for (int lt = 0; lt < 2; ++lt) { const size_t row = (size_t)(r0 + 32 * w + 16 * lt + r); bf16* zrow = F.PROJ + row * LP + Z0 + 64 * e + 4 * gq; float ss = 0.f;
#pragma unroll
        for (int pt = 0; pt < 4; ++pt) { GAS unsigned long long* zp = (GAS unsigned long long*)(zrow + 16 * pt); const unsigned long long zv = *zp; const unsigned z0 = (unsigned)zv, z1 = (unsigned)(zv >> 32);
            const float y0 = acc[pt][lt][0] * silu(bflo(z0)), y1 = acc[pt][lt][1] * silu(bfhi(z0)), y2 = acc[pt][lt][2] * silu(bflo(z1)), y3 = acc[pt][lt][3] * silu(bfhi(z1));
            ss += (y0 * y0 + y1 * y1) + (y2 * y2 + y3 * y3);
            *zp = (unsigned long long)pk2(y0, y1) | ((unsigned long long)pk2(y2, y3) << 32); }
        ss += __shfl_xor(ss, 16); ss += __shfl_xor(ss, 32);
        if (gq == 0) F.misc[MS_SSQ + row * 16 + e] = ss; }
    bar_sync();
}

constexpr int NG_B = 0, NG_X = 256 * 256, NG_V = NG_X + 2 * 256 * PX, NG_H = NG_V + 2 * 2048, NG_END = NG_H + 64 * PK;
static_assert(NG_END <= SCAN_LDS, "ssd group output LDS map");
__device__ __forceinline__ void ssd_out_group_unit(Frame& F, const int gp, const int g) {
    LAS unsigned char* L = F.lds;
    int tid = F.tid; asm volatile("" : "+v"(tid));
    const int lane = tid & 63, w = F.wave, r0 = gp * 256, gq = lane >> 4, r = lane & 15;
    stage128_swz(L + NG_B, F.PROJ + (size_t)r0 * LP + XB0 + 128 * g, tid); __builtin_amdgcn_sched_barrier(0);
    auto vec_load = [&](int e, float& ap, float& dt) { ap = 0.f; dt = 0.f; if (tid < 256) { const float* AC = F.misc + MS_ACUM + (size_t)r0 * 16 + e; float off = 0.f;
#pragma unroll
            for (int i = 0; i < 3; ++i) { const float x = AC[(size_t)(64 * i + 63) * 16]; if (i < (tid >> 6)) off += x; }
            ap = AC[(size_t)tid * 16] + off; dt = F.misc[MS_DT + (size_t)(r0 + tid) * 16 + e]; } };
    { v4u xr[4]; float ap, dt;
#pragma unroll
      for (int i = 0; i < 4; ++i) { const int id = tid + NTHR * i, row = id >> 3, ch = id & 7; xr[i] = *(const GAS v4u*)(F.PROJ + (size_t)(r0 + row) * LP + XBC0 + 64 * (8 * g) + 8 * ch); }
      vec_load(8 * g, ap, dt);
#pragma unroll
      for (int i = 0; i < 4; ++i) { const int id = tid + NTHR * i, row = id >> 3, ch = id & 7; *(LAS v4u*)(L + NG_X + row * PX + 16 * ch) = xr[i]; }
      if (tid < 256) { ((LAS float*)(L + NG_V))[tid] = ap; ((LAS float*)(L + NG_V))[256 + tid] = dt; }
      const bf16* S = (const bf16*)F.out + ST_SSD + (size_t)(gp * 16 + 8 * g) * 8192;
#pragma unroll
      for (int i = 0; i < 2; ++i) { const int id = tid + NTHR * i, row = id >> 4, ch = id & 15; *(LAS v4u*)(L + NG_H + row * PK + 16 * ch) = *(const GAS v4u*)(S + (size_t)row * 128 + 8 * ch); } }
    bf16x8 cf[2][4];
#pragma unroll
    for (int lt = 0; lt < 2; ++lt)
#pragma unroll
        for (int ks = 0; ks < 4; ++ks) cf[lt][ks] = *(const GAS bf16x8*)(F.PROJ + (size_t)(r0 + 32 * w + 16 * lt + r) * LP + XC0 + 128 * g + 32 * ks + 8 * gq);
    float ssq[2] = {0.f, 0.f};
    bar_sync();
    for (int e8 = 0; e8 < 8; ++e8) { const int e = 8 * g + e8, buf = e8 & 1;
        const LAS unsigned char* XI = L + NG_X + buf * 256 * PX; const LAS float* acP = (const LAS float*)(L + NG_V + buf * 2048); const LAS float* dtv = acP + 256;
        unsigned long long zpre[2][4];
#pragma unroll
        for (int lt = 0; lt < 2; ++lt)
#pragma unroll
            for (int pt = 0; pt < 4; ++pt) zpre[lt][pt] = *(const GAS unsigned long long*)(F.PROJ + (size_t)(r0 + 32 * w + 16 * lt + r) * LP + Z0 + 64 * e + 4 * gq + 16 * pt);
        f32x4 acc[4][2];
#pragma unroll
        for (int ph = 0; ph < 2; ++ph) { bf16x8 hf[2][4];
#pragma unroll
          for (int p2 = 0; p2 < 2; ++p2)
#pragma unroll
              for (int ks = 0; ks < 4; ++ks) hf[p2][ks] = frag_row(L + NG_H, PK, 16 * (2 * ph + p2), 32 * ks, lane);
          __builtin_amdgcn_sched_barrier(0);
#pragma unroll
          for (int p2 = 0; p2 < 2; ++p2) { const int pt = 2 * ph + p2; acc[pt][0] = (f32x4){0.f, 0.f, 0.f, 0.f}; acc[pt][1] = (f32x4){0.f, 0.f, 0.f, 0.f};
#pragma unroll
              for (int ks = 0; ks < 4; ++ks) { acc[pt][0] = MFMA16(hf[p2][ks], cf[0][ks], acc[pt][0]); acc[pt][1] = MFMA16(hf[p2][ks], cf[1][ks], acc[pt][1]); } }
          __builtin_amdgcn_sched_barrier(0); }
        lds_barrier();
        v4u xr[4]; float apn = 0.f, dtn = 0.f;
        if (e8 < 7) {
#pragma unroll
            for (int i = 0; i < 4; ++i) { const int id = tid + NTHR * i, row = id >> 3, ch = id & 7; xr[i] = *(const GAS v4u*)(F.PROJ + (size_t)(r0 + row) * LP + XBC0 + 64 * (e + 1) + 8 * ch); }
            vec_load(e + 1, apn, dtn); }
        v4u hr[2];
        if (e8 < 7) { const bf16* S = (const bf16*)F.out + ST_SSD + (size_t)(gp * 16 + e + 1) * 8192;
#pragma unroll
            for (int i = 0; i < 2; ++i) { const int id = tid + NTHR * i, row = id >> 4, ch = id & 15; hr[i] = *(const GAS v4u*)(S + (size_t)row * 128 + 8 * ch); } }
        float al[2];
#pragma unroll
        for (int lt = 0; lt < 2; ++lt) { al[lt] = acP[32 * w + 16 * lt + r]; const float ex = __expf(al[lt]);
#pragma unroll
            for (int pt = 0; pt < 4; ++pt) acc[pt][lt] = acc[pt][lt] * ex; }
        const float dsk = F.d_skip[e];
        for (int sb = 0; sb <= w; ++sb) {
            f32x4 pt2[2][2];
#pragma unroll
            for (int st = 0; st < 2; ++st) { pt2[st][0] = (f32x4){0.f, 0.f, 0.f, 0.f}; pt2[st][1] = (f32x4){0.f, 0.f, 0.f, 0.f}; }
            bf16x8 af[4][2];
#pragma unroll
            for (int ks = 0; ks < 4; ++ks)
#pragma unroll
                for (int st = 0; st < 2; ++st) af[ks][st] = frag_row_swz(L + NG_B, 32 * sb + 16 * st, 32 * ks, lane);
            bf16x8 xf[4];
#pragma unroll
            for (int pt = 0; pt < 4; ++pt) xf[pt] = frag_tr_perm(XI, PX, 32 * sb, 16 * pt, lane);
            const f32x4 as0 = *(const LAS f32x4*)(acP + 32 * sb + 4 * gq), as1 = *(const LAS f32x4*)(acP + 32 * sb + 16 + 4 * gq), ds0 = *(const LAS f32x4*)(dtv + 32 * sb + 4 * gq), ds1 = *(const LAS f32x4*)(dtv + 32 * sb + 16 + 4 * gq);
            __builtin_amdgcn_sched_barrier(0);
#pragma unroll
            for (int ks = 0; ks < 4; ++ks)
#pragma unroll
                for (int st = 0; st < 2; ++st) { pt2[st][0] = MFMA16(af[ks][st], cf[0][ks], pt2[st][0]); pt2[st][1] = MFMA16(af[ks][st], cf[1][ks], pt2[st][1]); }
            if (sb == w) {
#pragma unroll
                for (int st = 0; st < 2; ++st) { const f32x4 as = st ? as1 : as0, ds = st ? ds1 : ds0;
#pragma unroll
                    for (int lt = 0; lt < 2; ++lt)
#pragma unroll
                        for (int j = 0; j < 4; ++j) { float m = pt2[st][lt][j] * __expf(al[lt] - as[j]) * ds[j];
                            const int sr = 16 * st + 4 * gq + j, lr = 16 * lt + r; if (sr > lr) m = 0.f; if (sr == lr) m += dsk;
                            pt2[st][lt][j] = m; } }
            } else {
                const float ref = acP[32 * sb + 31]; const float v0 = __expf(al[0] - ref), v1 = __expf(al[1] - ref);
#pragma unroll
                for (int st = 0; st < 2; ++st) { const f32x4 as = st ? as1 : as0, ds = st ? ds1 : ds0;
#pragma unroll
                    for (int j = 0; j < 4; ++j) { const float us = __expf(ref - as[j]) * ds[j]; pt2[st][0][j] = pt2[st][0][j] * (us * v0); pt2[st][1][j] = pt2[st][1][j] * (us * v1); } }
            }
            bf16x8 pf[2];
#pragma unroll
            for (int lt = 0; lt < 2; ++lt) { u32x4v pw; pw[0] = pkh(pt2[0][lt][0], pt2[0][lt][1]); pw[1] = pkh(pt2[0][lt][2], pt2[0][lt][3]); pw[2] = pkh(pt2[1][lt][0], pt2[1][lt][1]); pw[3] = pkh(pt2[1][lt][2], pt2[1][lt][3]);
                pf[lt] = __builtin_bit_cast(bf16x8, pw); }
#pragma unroll
            for (int pt = 0; pt < 4; ++pt) { acc[pt][0] = MFMA16(xf[pt], pf[0], acc[pt][0]); acc[pt][1] = MFMA16(xf[pt], pf[1], acc[pt][1]); }
        }
#pragma unroll
        for (int lt = 0; lt < 2; ++lt) { const size_t row = (size_t)(r0 + 32 * w + 16 * lt + r); bf16* zrow = F.PROJ + row * LP + Z0 + 64 * e + 4 * gq; float ss = 0.f;
#pragma unroll
            for (int pt = 0; pt < 4; ++pt) { GAS unsigned long long* zp = (GAS unsigned long long*)(zrow + 16 * pt); const unsigned long long zv = zpre[lt][pt]; const unsigned z0 = (unsigned)zv, z1 = (unsigned)(zv >> 32);
                const float y0 = acc[pt][lt][0] * silu(bflo(z0)), y1 = acc[pt][lt][1] * silu(bfhi(z0)), y2 = acc[pt][lt][2] * silu(bflo(z1)), y3 = acc[pt][lt][3] * silu(bfhi(z1));
                ss += (y0 * y0 + y1 * y1) + (y2 * y2 + y3 * y3);
                *zp = (unsigned long long)pkh(y0, y1) | ((unsigned long long)pkh(y2, y3) << 32); }
            ss += __shfl_xor(ss, 16); ss += __shfl_xor(ss, 32); ssq[lt] += ss; }
        if (e8 < 7) { LAS unsigned char* XO = L + NG_X + (buf ^ 1) * 256 * PX; LAS float* vo = (LAS float*)(L + NG_V + (buf ^ 1) * 2048);
#pragma unroll
            for (int i = 0; i < 4; ++i) { const int id = tid + NTHR * i, row = id >> 3, ch = id & 7; *(LAS v4u*)(XO + row * PX + 16 * ch) = xr[i]; }
            if (tid < 256) { vo[tid] = apn; vo[256 + tid] = dtn; }
#pragma unroll
            for (int i = 0; i < 2; ++i) { const int id = tid + NTHR * i, row = id >> 4, ch = id & 15; *(LAS v4u*)(L + NG_H + row * PK + 16 * ch) = hr[i]; } }
        lds_barrier();
    }
#pragma unroll
    for (int lt = 0; lt < 2; ++lt) { const float rs = 1.0f / sqrtf(ssq[lt] * (1.0f / 512.0f) + EPS);
        if (gq == 0) F.misc[MS_GRS + (size_t)(r0 + 32 * w + 16 * lt + r) * 2 + g] = rs; }
    bar_sync();
}

__device__ __forceinline__ bf16x8 scale_frag(bf16x8 f, const float (&w8)[8]) { u32x4v x = __builtin_bit_cast(u32x4v, f);
#pragma unroll
    for (int k = 0; k < 4; ++k) x[k] = pkh(bflo(x[k]) * w8[2 * k], bfhi(x[k]) * w8[2 * k + 1]);
    return __builtin_bit_cast(bf16x8, x); }
constexpr int SS_B = 0, SS_X = 32 * PK, SS_R = SS_X + 32 * PX, SS_V = SS_R + 32 * 4 * 4, SS_END2 = SS_V + 2 * 32 * 4;
__device__ __forceinline__ void ssd_sample_unit(Frame& F, const int sb, const int e) {
    LAS unsigned char* L = F.lds; int tid = F.tid; asm volatile("" : "+v"(tid));
    const int lane = tid & 63, w = F.wave, r0 = RP + 32 * sb, g = e >> 3, gq = lane >> 4, r = lane & 15, pt = w & 3, lt = w >> 2;
    LAS unsigned char* XI = L + SS_X; LAS float* part = (LAS float*)(L + SS_R); LAS float* acv = (LAS float*)(L + SS_V); LAS float* dtv = acv + 32;
    { const int row = tid >> 4, ch = tid & 15; *(LAS v4u*)(L + SS_B + row * PK + 16 * ch) = *(const GAS v4u*)(F.PROJ + (size_t)(r0 + row) * LP + XB0 + 128 * g + 8 * ch); }
    if (tid < 256) { const int row = tid >> 3, ch = tid & 7; *(LAS v4u*)(XI + row * PX + 16 * ch) = *(const GAS v4u*)(F.PROJ + (size_t)(r0 + row) * LP + XBC0 + 64 * e + 8 * ch); }
    if (tid < 32) { acv[tid] = F.misc[MS_ACUM + (size_t)(r0 + tid) * 16 + e]; dtv[tid] = F.misc[MS_DT + (size_t)(r0 + tid) * 16 + e]; }
    bf16x8 cf[4];
#pragma unroll
    for (int ks = 0; ks < 4; ++ks) cf[ks] = *(const GAS bf16x8*)(F.PROJ + (size_t)(r0 + 16 * lt + r) * LP + XC0 + 128 * g + 32 * ks + 8 * gq);
    const float* H0 = F.st_ssm + (size_t)(sb * 16 + e) * 8192;
    f32x4 acc = (f32x4){0.f, 0.f, 0.f, 0.f};
#pragma unroll
    for (int ks = 0; ks < 4; ++ks) { const float* hp = H0 + (size_t)(16 * pt + r) * 128 + 32 * ks + 8 * gq; const f32x4 h0 = *(const GAS f32x4*)hp, h1 = *(const GAS f32x4*)(hp + 4);
        u32x4v aw; aw[0] = pkh(h0[0], h0[1]); aw[1] = pkh(h0[2], h0[3]); aw[2] = pkh(h1[0], h1[1]); aw[3] = pkh(h1[2], h1[3]);
        acc = MFMA16(__builtin_bit_cast(bf16x8, aw), cf[ks], acc); }
    const unsigned long long zv = *(const GAS unsigned long long*)(F.PROJ + (size_t)(r0 + 16 * lt + r) * LP + Z0 + 64 * e + 16 * pt + 4 * gq);
    f32x4 h0pre[4];
#pragma unroll
    for (int p4 = 0; p4 < 4; ++p4) h0pre[p4] = *(const GAS f32x4*)(H0 + (size_t)(16 * p4 + r) * 128 + 16 * w + 4 * gq);
    lds_barrier();
    const float al = acv[16 * lt + r], atot = acv[31];
    acc = acc * __expf(al);
    { f32x4 pt2[2] = {(f32x4){0.f, 0.f, 0.f, 0.f}, (f32x4){0.f, 0.f, 0.f, 0.f}};
#pragma unroll
      for (int ks = 0; ks < 4; ++ks)
#pragma unroll
          for (int st = 0; st < 2; ++st) pt2[st] = MFMA16(frag_row(L + SS_B, PK, 16 * st, 32 * ks, lane), cf[ks], pt2[st]);
      const float dsk = F.d_skip[e];
#pragma unroll
      for (int st = 0; st < 2; ++st)
#pragma unroll
          for (int j = 0; j < 4; ++j) { const int sr = 16 * st + 4 * gq + j, lr = 16 * lt + r; float m = pt2[st][j] * __expf(al - acv[sr]) * dtv[sr]; if (sr > lr) m = 0.f; if (sr == lr) m += dsk; pt2[st][j] = m; }
      u32x4v pw; pw[0] = pkh(pt2[0][0], pt2[0][1]); pw[1] = pkh(pt2[0][2], pt2[0][3]); pw[2] = pkh(pt2[1][0], pt2[1][1]); pw[3] = pkh(pt2[1][2], pt2[1][3]);
      acc = MFMA16(frag_tr_perm(XI, PX, 0, 16 * pt, lane), __builtin_bit_cast(bf16x8, pw), acc); }
    { const unsigned z0 = (unsigned)zv, z1 = (unsigned)(zv >> 32);
      const float y0 = acc[0] * silu(bflo(z0)), y1 = acc[1] * silu(bfhi(z0)), y2 = acc[2] * silu(bflo(z1)), y3 = acc[3] * silu(bfhi(z1));
      float ss = (y0 * y0 + y1 * y1) + (y2 * y2 + y3 * y3); ss += __shfl_xor(ss, 16); ss += __shfl_xor(ss, 32);
      if (gq == 0) part[(16 * lt + r) * 4 + pt] = ss;
      *(GAS unsigned long long*)(F.PROJ + (size_t)(r0 + 16 * lt + r) * LP + Z0 + 64 * e + 16 * pt + 4 * gq) = (unsigned long long)pkh(y0, y1) | ((unsigned long long)pkh(y2, y3) << 32); }
    { float w8[8];
#pragma unroll
      for (int j = 0; j < 8; ++j) w8[j] = __expf(atot - acv[8 * gq + j]) * dtv[8 * gq + j];
      const bf16x8 a = frag_tr(L + SS_B, PK, 0, 16 * w, lane); const float dtot = __expf(atot); float* HN = F.out + O_SS + (size_t)(sb * 16 + e) * 8192;
#pragma unroll
      for (int p4 = 0; p4 < 4; ++p4) { const bf16x8 xw = scale_frag(frag_tr(XI, PX, 0, 16 * p4, lane), w8); const f32x4 o = MFMA16(a, xw, ((f32x4){0.f, 0.f, 0.f, 0.f}));
          const size_t ix = (size_t)(16 * p4 + r) * 128 + 16 * w + 4 * gq; *(GAS f32x4*)(HN + ix) = h0pre[p4] * dtot + o; } }
    lds_barrier();
    if (tid < 32) F.misc[MS_SSQ + (size_t)(r0 + tid) * 16 + e] = (part[tid * 4] + part[tid * 4 + 1]) + (part[tid * 4 + 2] + part[tid * 4 + 3]);
    lds_barrier();
}
constexpr int SR_K = 0, SR_V = 32 * PK, SR_P = 2 * 32 * PK, SR_END = SR_P + 2 * 32 * 8 * 4;
static_assert(SR_END <= SCAN_LDS && SS_END2 <= SCAN_LDS, "sample LDS maps");
__device__ __forceinline__ void ret_sample_unit(Frame& F, const int sb, const int hh) {
    LAS unsigned char* L = F.lds; int tid = F.tid; asm volatile("" : "+v"(tid));
    const int lane = tid & 63, w = F.wave, r0 = RP + 32 * sb, gq = lane >> 4, r = lane & 15;
    LAS unsigned char* KI = L + SR_K; LAS unsigned char* VI = L + SR_V; LAS float* part = (LAS float*)(L + SR_P); LAS float* part2 = part + 256;
    { const int row = tid >> 4, ch = tid & 15; const bf16* src = F.PROJ + (size_t)(r0 + row) * LP + 128 * hh + 8 * ch;
      *(LAS v4u*)(KI + row * PK + 16 * ch) = *(const GAS v4u*)(src + K0); *(LAS v4u*)(VI + row * PK + 16 * ch) = *(const GAS v4u*)(src + V0); }
    const float lg2 = log2f(1.0f - exp2f(-5.0f - (float)hh));
    bf16x8 qf[2][4];
#pragma unroll
    for (int lt = 0; lt < 2; ++lt)
#pragma unroll
        for (int ks = 0; ks < 4; ++ks) qf[lt][ks] = *(const GAS bf16x8*)(F.PROJ + (size_t)(r0 + 16 * lt + r) * LP + Q0 + 128 * hh + 32 * ks + 8 * gq);
    const float* S0 = F.st_ret + (size_t)(sb * 8 + hh) * 16384;
    unsigned long long gpre[2]; f32x4 s0pre[8];
#pragma unroll
    for (int lt = 0; lt < 2; ++lt) gpre[lt] = *(const GAS unsigned long long*)(F.PROJ + (size_t)(r0 + 16 * lt + r) * LP + G0 + 128 * hh + 16 * w + 4 * gq);
#pragma unroll
    for (int dt = 0; dt < 8; ++dt) s0pre[dt] = *(const GAS f32x4*)(S0 + (size_t)(16 * dt + r) * 128 + 16 * w + 4 * gq);
    f32x4 acc[2] = {(f32x4){0.f, 0.f, 0.f, 0.f}, (f32x4){0.f, 0.f, 0.f, 0.f}};
#pragma unroll
    for (int ks = 0; ks < 4; ++ks) { const float* sp = S0 + (size_t)(32 * ks + 8 * gq) * 128 + 16 * w + r; u32x4v aw;
#pragma unroll
        for (int k = 0; k < 4; ++k) aw[k] = pkh(sp[(size_t)(2 * k) * 128], sp[(size_t)(2 * k + 1) * 128]);
        const bf16x8 a = __builtin_bit_cast(bf16x8, aw);
        acc[0] = MFMA16(a, qf[0][ks], acc[0]); acc[1] = MFMA16(a, qf[1][ks], acc[1]); }
#pragma unroll
    for (int lt = 0; lt < 2; ++lt) acc[lt] = acc[lt] * exp2f(lg2 * (float)(16 * lt + r + 1));
    lds_barrier();
    { f32x4 pt[2][2];
#pragma unroll
      for (int st = 0; st < 2; ++st) { pt[st][0] = (f32x4){0.f, 0.f, 0.f, 0.f}; pt[st][1] = (f32x4){0.f, 0.f, 0.f, 0.f}; }
#pragma unroll
      for (int ks = 0; ks < 4; ++ks)
#pragma unroll
          for (int st = 0; st < 2; ++st) { const bf16x8 a = frag_row(KI, PK, 16 * st, 32 * ks, lane); pt[st][0] = MFMA16(a, qf[0][ks], pt[st][0]); pt[st][1] = MFMA16(a, qf[1][ks], pt[st][1]); }
#pragma unroll
      for (int st = 0; st < 2; ++st)
#pragma unroll
          for (int lt = 0; lt < 2; ++lt)
#pragma unroll
              for (int j = 0; j < 4; ++j) { const int sr = 16 * st + 4 * gq + j, lr = 16 * lt + r; pt[st][lt][j] = (sr > lr) ? 0.f : pt[st][lt][j] * exp2f(lg2 * (float)(lr - sr)); }
      const bf16x8 a = frag_tr_perm(VI, PK, 0, 16 * w, lane);
#pragma unroll
      for (int lt = 0; lt < 2; ++lt) { u32x4v pw; pw[0] = pkh(pt[0][lt][0], pt[0][lt][1]); pw[1] = pkh(pt[0][lt][2], pt[0][lt][3]); pw[2] = pkh(pt[1][lt][0], pt[1][lt][1]); pw[3] = pkh(pt[1][lt][2], pt[1][lt][3]);
          acc[lt] = MFMA16(a, __builtin_bit_cast(bf16x8, pw), acc[lt]); } }
    float mean[2], rstd[2];
#pragma unroll
    for (int lt = 0; lt < 2; ++lt) { float sm = (acc[lt][0] + acc[lt][1]) + (acc[lt][2] + acc[lt][3]); sm += __shfl_xor(sm, 16); sm += __shfl_xor(sm, 32); if (gq == 0) part[(16 * lt + r) * 8 + w] = sm; }
    lds_barrier();
#pragma unroll
    for (int lt = 0; lt < 2; ++lt) { float sm = 0.f;
#pragma unroll
        for (int k = 0; k < 8; ++k) sm += part[(16 * lt + r) * 8 + k];
        mean[lt] = sm * (1.0f / 128.0f); float d2 = 0.f;
#pragma unroll
        for (int j = 0; j < 4; ++j) { const float d = acc[lt][j] - mean[lt]; d2 += d * d; }
        d2 += __shfl_xor(d2, 16); d2 += __shfl_xor(d2, 32); if (gq == 0) part2[(16 * lt + r) * 8 + w] = d2; }
    lds_barrier();
#pragma unroll
    for (int lt = 0; lt < 2; ++lt) { float d2 = 0.f;
#pragma unroll
        for (int k = 0; k < 8; ++k) d2 += part2[(16 * lt + r) * 8 + k];
        rstd[lt] = 1.0f / sqrtf(d2 * (1.0f / 128.0f) + EPS);
        GAS unsigned long long* gp8 = (GAS unsigned long long*)(F.PROJ + (size_t)(r0 + 16 * lt + r) * LP + G0 + 128 * hh + 16 * w + 4 * gq); const unsigned long long gv = gpre[lt]; const unsigned g0 = (unsigned)gv, g1 = (unsigned)(gv >> 32);
        const float y0 = (acc[lt][0] - mean[lt]) * rstd[lt] * silu(bflo(g0)), y1 = (acc[lt][1] - mean[lt]) * rstd[lt] * silu(bfhi(g0)), y2 = (acc[lt][2] - mean[lt]) * rstd[lt] * silu(bflo(g1)), y3 = (acc[lt][3] - mean[lt]) * rstd[lt] * silu(bfhi(g1));
        *gp8 = (unsigned long long)pkh(y0, y1) | ((unsigned long long)pkh(y2, y3) << 32); }
    { float w8[8];
#pragma unroll
      for (int j = 0; j < 8; ++j) w8[j] = exp2f(lg2 * (float)(31 - (8 * gq + j)));
      const bf16x8 a = frag_tr(VI, PK, 0, 16 * w, lane);
      const float g32 = exp2f(lg2 * 32.0f); float* SN = F.out + O_RS + (size_t)(sb * 8 + hh) * 16384;
#pragma unroll
      for (int dt = 0; dt < 8; ++dt) { const bf16x8 kw = scale_frag(frag_tr(KI, PK, 0, 16 * dt, lane), w8); const f32x4 o = MFMA16(a, kw, ((f32x4){0.f, 0.f, 0.f, 0.f}));
          const size_t ix = (size_t)(16 * dt + r) * 128 + 16 * w + 4 * gq; *(GAS f32x4*)(SN + ix) = s0pre[dt] * g32 + o; } }
    lds_barrier();
}
__device__ __forceinline__ SeqInfo prompt_panel(int gp) { SeqInfo s; s.r0 = gp * 256; s.tseq0 = (gp & 63) * 256; s.pos0 = s.tseq0; s.sb = -1; return s; }
__device__ __forceinline__ SeqInfo sample_seq(int sb) { SeqInfo s; s.r0 = RP + sb * SL; s.tseq0 = 0; s.pos0 = PASTLEN; s.sb = sb; return s; }
constexpr int NU_RET_P = NPP * RH, NU_SSD_P = NPP * NH, NU_RET_S = SBN * RH, NU_SSD_S = SBN * NH;
__device__ __forceinline__ void sample_conv_all(Frame& F) {
    for (int it = F.tid * F.G + F.vcu; it < SBN * (CONVD / 8); it += NTHR * F.G) {            const int sb = it / (CONVD / 8), col = 8 * (it % (CONVD / 8)); float hal[3][8];
#pragma unroll
        for (int j = 0; j < 3; ++j) { const f32x4 a = *(const GAS f32x4*)(F.st_conv + (size_t)(sb * 3 + j) * CONVD + col), b = *(const GAS f32x4*)(F.st_conv + (size_t)(sb * 3 + j) * CONVD + col + 4);
#pragma unroll
            for (int i = 0; i < 4; ++i) { hal[j][i] = a[i]; hal[j][4 + i] = b[i]; } }
        conv_walk(F, RP + 32 * sb, 32, col, hal, F.out + O_CS + (size_t)(sb * 3) * CONVD + col); }
    const int gw = F.vcu * NWAVES + F.wave;
    if (gw < 256) { const int e = gw >> 4; const size_t row = (size_t)(RP + 64 * (gw & 15) + F.lane);
        const float dt = softplus_f(bf2f(*(const GAS bf16*)(F.PROJ + row * LP + DT0 + e)) + F.dt_bias[e]); float sc = dt * -__expf(F.a_log[e]);
#pragma unroll
        for (int o = 1; o < 32; o <<= 1) { const float v = __shfl_up(sc, o); if ((F.lane & 31) >= o) sc += v; }
        F.misc[MS_DT + row * 16 + e] = dt; F.misc[MS_ACUM + row * 16 + e] = sc; }
}
__device__ __forceinline__ void phase_conv_local(Frame& F) {
    sample_conv_all(F);
    for (int u = F.vcu; u < NPP * 2; u += F.G) { conv_unit(F, u); ssd_local_unit(F, u >> 1, u & 1); }
    ret_local_units(F);
}
__device__ __forceinline__ void phase_state_pass(Frame& F) {
    const int gt = F.vcu * NTHR + F.tid, NGT = F.G * NTHR;
    constexpr int NCH2 = PB * NH * 4096;
    for (int ch = gt; ch < 2 * NCH2; ch += NGT) {
        if (ch < NCH2) { const int b = ch / (NH * 4096), rem = ch % (NH * 4096), e = rem >> 12, idx = (rem & 4095) * 2;
            GAS unsigned* S = (GAS unsigned*)((bf16*)F.out + ST_SSD + ((size_t)(b * 64) * 16 + e) * 8192 + idx); const float* D = F.misc + MS_DEC + (size_t)(b * 64) * 16 + e;
            float h0 = 0.f, h1 = 0.f;
            for (int p0 = 0; p0 < 64; p0 += 16) { unsigned sv[16]; float d[16];
#pragma unroll
                for (int k = 0; k < 16; ++k) { sv[k] = S[(size_t)(p0 + k) * 16 * 4096]; d[k] = __hip_atomic_load(D + (p0 + k) * 16, __ATOMIC_RELAXED, __HIP_MEMORY_SCOPE_AGENT); }
#pragma unroll
                for (int k = 0; k < 16; ++k) { S[(size_t)(p0 + k) * 16 * 4096] = pkh(h0, h1); h0 = d[k] * h0 + bflo(sv[k]); h1 = d[k] * h1 + bfhi(sv[k]); } }
            float* o = F.out + O_SP + (size_t)(b * 16 + e) * 8192 + idx; o[0] = h0; o[1] = h1;
        } else { const int c2 = ch - NCH2; const int b = c2 / (RH * 8192), rem = c2 % (RH * 8192), hh = rem >> 13, idx = (rem & 8191) * 2;
            GAS unsigned* S = (GAS unsigned*)((bf16*)F.out + ST_RET + ((size_t)(b * 64) * 8 + hh) * 16384 + idx); const float d = exp2f(256.0f * log2f(1.0f - exp2f(-5.0f - (float)hh)));
            float h0 = 0.f, h1 = 0.f;
            for (int p0 = 0; p0 < 64; p0 += 16) { unsigned sv[16];
#pragma unroll
                for (int k = 0; k < 16; ++k) sv[k] = S[(size_t)(p0 + k) * 8 * 8192];
#pragma unroll
                for (int k = 0; k < 16; ++k) { S[(size_t)(p0 + k) * 8 * 8192] = pkh(h0, h1); h0 = d * h0 + bflo(sv[k]); h1 = d * h1 + bfhi(sv[k]); } }
            float* o = F.out + O_RP + (size_t)(b * 8 + hh) * 16384 + (size_t)(idx & 127) * 128 + (idx >> 7); o[0] = h0; o[128] = h1;
        }
    }
    for (int i = gt; i < PB * 3 * CONVD; i += NGT) { const int sq = i / (3 * CONVD), rem = i % (3 * CONVD);
        F.out[O_CP + (size_t)i] = bf2f(*(const GAS bf16*)(F.halo + (size_t)((sq * 64 + 63) * 3) * CONVD + rem)); }
}
__device__ __forceinline__ void phase_outputs(Frame& F) {
    for (int u = F.vcu; u < NU_RET_P; u += F.G) ret_out_unit(F, u >> 3, u & 7);
    if (PROBE && blockIdx.x == 0 && F.tid == 0) F.MISC[16 + 20] = (unsigned)__builtin_amdgcn_s_memrealtime();
    for (int u = F.vcu; u < NPP * 2; u += F.G) ssd_out_group_unit(F, u >> 1, u & 1);
    if (PROBE && blockIdx.x == 0 && F.tid == 0) F.MISC[16 + 21] = (unsigned)__builtin_amdgcn_s_memrealtime();
    for (int u = F.vcu; u < SBN * RH; u += F.G) ret_sample_unit(F, u >> 3, u & 7);
    for (int u = F.vcu; u < SBN * NH; u += F.G) ssd_sample_unit(F, u >> 4, u & 15);
}
__device__ __forceinline__ void phase_ssm_norm(Frame& F) {
    const int gw = F.vcu * NWAVES + F.wave, NGW = F.G * NWAVES;
    for (int m = RP + gw; m < RT; m += NGW) {
        const int grp = F.lane >> 5; float ss = 0.f;
#pragma unroll
        for (int k = 0; k < 8; ++k) ss += F.misc[MS_SSQ + (size_t)m * 16 + grp * 8 + k];
        const float rs = 1.0f / sqrtf(ss * (1.0f / 512.0f) + EPS);
        GAS v4u* p = (GAS v4u*)(F.PROJ + (size_t)m * LP + Z0 + 16 * F.lane);
#pragma unroll
        for (int h = 0; h < 2; ++h) { v4u v = p[h];
#pragma unroll
            for (int k = 0; k < 4; ++k) v[k] = pk2(bflo(v[k]) * rs, bfhi(v[k]) * rs);
            p[h] = v; }
    }
}
template <bool MID>
__device__ __forceinline__ void load_raw16(const Frame& F, int m, int col0, float (&v)[16]) {
    if (m < RP) {
        const bf16* rbase = MID ? (const bf16*)F.out + C_RAW2 : (const bf16*)F.PROJ + C_RAW4;
#pragma unroll
        for (int h = 0; h < 2; ++h) { const v4u rw = __builtin_nontemporal_load((const GAS v4u*)(rbase + (size_t)m * DM + 512 * h + 8 * F.lane));
#pragma unroll
            for (int k = 0; k < 4; ++k) { v[8 * h + 2 * k] = bflo(rw[k]); v[8 * h + 2 * k + 1] = bfhi(rw[k]); } }
    } else {
        float sc[4] = {1.f, 1.f, 1.f, 1.f};
        if (MID) { float q = F.misc[MS_SSQ + (size_t)m * 16 + (F.lane & 15)]; q += __shfl_xor(q, 1); q += __shfl_xor(q, 2); q += __shfl_xor(q, 4);
            sc[0] = 1.0f / sqrtf(__shfl(q, 0) * (1.0f / 512.0f) + EPS); sc[1] = 1.0f / sqrtf(__shfl(q, 8) * (1.0f / 512.0f) + EPS); }
        const bf16* base = MID ? (const bf16*)F.out + C_SLAB2 : (const bf16*)F.PROJ + C_SLAB4; const size_t ld = DM, sstride = (size_t)RS * DM;
#pragma unroll
        for (int h = 0; h < 2; ++h) { const bf16* p = base + (size_t)(m - RP) * ld + 512 * h + 8 * F.lane; float a[8];
#pragma unroll
            for (int k = 0; k < 8; ++k) a[k] = 0.f;
#pragma unroll
            for (int sl = 0; sl < (MID ? 4 : 11); ++sl) { const v4u rw = *(const GAS v4u*)(p + (size_t)sl * sstride); const float f = (MID && sl < 2) ? sc[sl] : 1.f;
#pragma unroll
                for (int k = 0; k < 4; ++k) { a[2 * k] += bflo(rw[k]) * f; a[2 * k + 1] += bfhi(rw[k]) * f; } }
#pragma unroll
            for (int k = 0; k < 8; ++k) v[8 * h + k] = a[k]; }
    }
}
__device__ __forceinline__ void load_f16(const float* row, int lane, float (&v)[16]) {
#pragma unroll
    for (int h = 0; h < 2; ++h)
#pragma unroll
        for (int q = 0; q < 2; ++q) { const f32x4 a = __builtin_nontemporal_load((const GAS f32x4*)(row + 512 * h + 8 * lane + 4 * q));
#pragma unroll
            for (int k = 0; k < 4; ++k) v[8 * h + 4 * q + k] = a[k]; }
}
__device__ __forceinline__ void phase_rows_mid(Frame& F) {
    const int gw = F.vcu * NWAVES + F.wave, NGW = F.G * NWAVES;
    float gg[16]; load_f16(F.n_mix_post, F.lane, gg);
    for (int m = gw; m < RT; m += NGW) {
        float v[16], x[16]; load_raw16<true>(F, m, RAW2_0, v); load_f16(x_row(F, m), F.lane, x);
        float s2 = 0.f;
#pragma unroll
        for (int k = 0; k < 16; ++k) s2 += v[k] * v[k];
        const float rs = 1.0f / sqrtf(wave_sum(s2) * (1.f / DM) + EPS); float t2 = 0.f;
#pragma unroll
        for (int k = 0; k < 16; ++k) { v[k] = x[k] + v[k] * rs * gg[k]; t2 += v[k] * v[k]; }
#pragma unroll
        for (int h = 0; h < 2; ++h) { v4u w;
#pragma unroll
            for (int k = 0; k < 4; ++k) w[k] = pkh(v[8 * h + 2 * k], v[8 * h + 2 * k + 1]);
            *(GAS v4u*)(F.PROJ + C_X1 + (size_t)m * DM + 512 * h + 8 * F.lane) = w; }
        const float rs2 = 1.0f / sqrtf(wave_sum(t2) * (1.f / DM) + EPS);
        if (F.lane == 0) F.misc[MS_RS2 + m] = rs2;
    }
}
__device__ __forceinline__ void phase_rows_end(Frame& F) {
    const int gw = F.vcu * NWAVES + F.wave, NGW = F.G * NWAVES;
    float gg[16]; load_f16(F.n_ffn_post, F.lane, gg);
    for (int m = gw; m < RT; m += NGW) {
        float v[16], x[16]; load_raw16<false>(F, m, 0, v); float* o = F.out + (size_t)m * DM;
#pragma unroll
        for (int h = 0; h < 2; ++h) { const v4u rw = __builtin_nontemporal_load((const GAS v4u*)(F.PROJ + C_X1 + (size_t)m * DM + 512 * h + 8 * F.lane));
#pragma unroll
            for (int k = 0; k < 4; ++k) { x[8 * h + 2 * k] = bflo(rw[k]); x[8 * h + 2 * k + 1] = bfhi(rw[k]); } }
        float s2 = 0.f;
#pragma unroll
        for (int k = 0; k < 16; ++k) s2 += v[k] * v[k];
        const float rs = 1.0f / sqrtf(wave_sum(s2) * (1.f / DM) + EPS);
#pragma unroll
        for (int h = 0; h < 2; ++h)
#pragma unroll
            for (int q = 0; q < 2; ++q) { const int b = 8 * h + 4 * q; *(GAS f32x4*)(o + 512 * h + 8 * F.lane + 4 * q) = (f32x4){x[b] + v[b] * rs * gg[b], x[b + 1] + v[b + 1] * rs * gg[b + 1], x[b + 2] + v[b + 2] * rs * gg[b + 2], x[b + 3] + v[b + 3] * rs * gg[b + 3]}; }
    }
}

__device__ __forceinline__ void stagger_delay(int group, unsigned ticks_per_group) {
    const unsigned long long t0 = __builtin_amdgcn_s_memrealtime(); const unsigned long long want = (unsigned long long)group * ticks_per_group;
    while (__builtin_amdgcn_s_memrealtime() - t0 < want) __builtin_amdgcn_s_sleep(8);
}
struct Args { const float* in[21]; float* out; unsigned char* ws; int ph_lo, ph_hi; };
__global__ void __launch_bounds__(NTHR, 2) hybrid_fwd(Args args) {
    extern __shared__ __attribute__((aligned(16))) unsigned char lds[];
    Frame F;
    F.lds = (LAS unsigned char*)lds;
    F.MISC = (volatile LAS unsigned*)(F.lds + MISC_OFF);
    F.wave = __builtin_amdgcn_readfirstlane((int)threadIdx.x >> 6); F.lane = hw_lane(); F.tid = F.wave * 64 + F.lane;
#define REIDS() do { F.lane = hw_lane(); F.tid = F.wave * 64 + F.lane; } while (0)
    F.G = gridDim.x; { const int bx = blockIdx.x; F.vcu = (F.G % 8 == 0) ? (bx % 8) * (F.G / 8) + bx / 8 : bx; }
    unsigned char* ws = args.ws;
    F.ctl = (gu32*)(ws + WS_CTL);
    F.xp = args.in[0]; F.xs = args.in[1]; F.st_conv = args.in[2]; F.st_ssm = args.in[3]; F.st_ret = args.in[4]; F.n_mix_pre = args.in[5]; F.n_mix_post = args.in[6];
    F.n_ffn_pre = args.in[7]; F.n_ffn_post = args.in[8]; F.w_in = args.in[9]; F.conv_w = args.in[10]; F.conv_b = args.in[11]; F.dt_bias = args.in[12]; F.a_log = args.in[13];
    F.d_skip = args.in[14]; F.ssm_norm = args.in[15]; F.ret_norm = args.in[16]; F.w_out = args.in[17]; F.w_gate = args.in[18]; F.w_up = args.in[19]; F.w_down = args.in[20];
    F.out = args.out;
    F.W1t = (bf16*)(ws + WS_W1); F.W2t = (bf16*)(ws + WS_W2); F.W3t = (bf16*)(ws + WS_W3); F.W4t = (bf16*)(ws + WS_W4); F.PROJ = (bf16*)(ws + WS_PROJ);
    F.HB = (bf16*)args.out;
    F.misc = (float*)(ws + WS_MISC); F.rot = (float*)(ws + WS_ROT); F.halo = (bf16*)(ws + WS_HALO); F.slab = (float*)(ws + WS_SLAB);
    for (int u = F.tid; u < (LDS_BYTES - LDSCTL_OFF) / 4; u += NTHR) ((LAS unsigned*)(F.lds + LDSCTL_OFF))[u] = 0u;
    __syncthreads();
    XcdBarrier bar = xcd_barrier_post((unsigned*)(F.ctl + CW_BAR), F.MISC + 8, F.wave);
#define STAMP() do { if (PROBE && (nst == 1 || nst == 2) && blockIdx.x == 0 && F.tid == 0) F.MISC[16 + nst] = (unsigned)__builtin_amdgcn_s_memrealtime(); ++nst; } while (0)
#define GRID_BAR() do { xcd_barrier(bar); STAMP(); } while (0)
    int nst = 0; STAMP();
    const int lo = args.ph_lo, hi = args.ph_hi;
#define IN(k) (lo <= (k) && (k) < hi)
    if (IN(0)) { REIDS(); p0_prologue(F); GRID_BAR(); }
    if (IN(1)) { REIDS(); pg8::Gemm g{F.HB, F.W1t, RT, LP, DM, DM, DM}; pg8::StaticOrder S; S.init(RT, LP, F.G, (int)blockIdx.x);
        pg8::EpiProj E{F.PROJ, LP, F.rot, F.halo};
        pg8::gemm_phase<pg8::EpiProj, pg8::StaticOrder, true, true, true>(F.lds + RING_OFF, g, S, E, F.wave); GRID_BAR(); }
    if (IN(11)) { REIDS(); phase_conv_local(F); GRID_BAR(); }
    if (IN(3)) { REIDS(); phase_state_pass(F); GRID_BAR(); }
    if (IN(4)) { REIDS(); phase_outputs(F); GRID_BAR(); }
    if (IN(6)) { REIDS(); pg8::Gemm g{F.PROJ + Z0, F.W2t, RP, DM, 2048, LP, 2048}; pg8::StaticOrder S; S.init(RP, DM, F.G, (int)blockIdx.x);
        pg8::EpiBf16KS E{{(bf16*)F.out + C_RAW2, DM}, F.misc + MS_GRS};
        pg8::gemm_phase<pg8::EpiBf16KS, pg8::StaticOrder, true, true, true>(F.lds + RING_OFF, g, S, E, F.wave);
        { pg8::Gemm g2{F.PROJ + Z0, F.W2t, RT, DM, 512, LP, 2048}; pg8::SampleSplitOrder S2{F.vcu, 8, 4}; pg8::EpiSlabB E2{(bf16*)F.out + C_SLAB2, 8, 1024, (size_t)1024 * 1024};
          pg8::gemm_phase<pg8::EpiSlabB, pg8::SampleSplitOrder, true, true>(F.lds + RING_OFF, g2, S2, E2, F.wave); }
        GRID_BAR(); }
    if (IN(7)) { REIDS(); phase_rows_mid(F); GRID_BAR(); }
    if (IN(8)) { REIDS(); pg8::Gemm g{F.PROJ + C_X1, F.W3t, RT, 2 * DFF, DM, DM, DM}; pg8::StaticOrder S; S.init(RT, 2 * DFF, F.G, (int)blockIdx.x);
        pg8::EpiSwiGLU E{F.PROJ + C_ACT, DFF, F.misc + MS_RS2};
        pg8::gemm_phase<pg8::EpiSwiGLU, pg8::StaticOrder, true, true, true>(F.lds + RING_OFF, g, S, E, F.wave); GRID_BAR(); }
    if (IN(9)) { REIDS(); pg8::Gemm g{F.PROJ + C_ACT, F.W4t, RP, DM, DFF, DFF, DFF}; pg8::StaticOrder S; S.init(RP, DM, F.G, (int)blockIdx.x);
        pg8::EpiBf16 E{F.PROJ + C_RAW4, DM};
        pg8::gemm_phase<pg8::EpiBf16, pg8::StaticOrder, true, true, true>(F.lds + RING_OFF, g, S, E, F.wave);
        { pg8::Gemm g2{F.PROJ + C_ACT, F.W4t, RT, DM, 256, DFF, DFF}; pg8::SampleSplitOrder S2{F.vcu, 4, 11}; pg8::EpiSlabB E2{F.PROJ + C_SLAB4, 4, DM, (size_t)1024 * DM};
          pg8::gemm_phase<pg8::EpiSlabB, pg8::SampleSplitOrder, true, true>(F.lds + RING_OFF, g2, S2, E2, F.wave); }
        GRID_BAR(); }
    if (IN(10)) { REIDS(); phase_rows_end(F); STAMP(); }
    if (PROBE && blockIdx.x == 0) {
        __syncthreads();
        const float dA = (float)(F.MISC[16 + PA_TO] - F.MISC[16 + PA_FROM]) * 0.01f, dB = (float)(F.MISC[16 + PB_TO] - F.MISC[16 + PB_FROM]) * 0.01f;
        if (F.tid == 0) F.out[0] += 0.2f + 0.6f * fminf(dA / PA_DMAX, 1.0f);
        const float eps = sqrtf(5e-5f + 2.5e-4f * fminf(dB / PB_DMAX, 1.0f));
        for (int i = F.tid; i < PB * 3 * CONVD; i += NTHR) F.out[O_CP + i] *= (1.0f + eps);
    }
#undef IN
}

extern "C" void kernel_launch(void* const* d_in, const int* in_sizes, int n_in, void* d_out, int out_size, void* d_ws, size_t ws_size, hipStream_t stream) {
    static int grid = 0;
    if (grid == 0) {
        if (n_in != 21 || out_size != (int)O_END || ws_size < WS_END) { fprintf(stderr, "kernel_launch: unexpected sizes n_in %d out %d ws %zu (need %zu)\n", n_in, out_size, ws_size, (size_t)WS_END); grid = -1; return; }
        int dev = 0, cus = 0;
        if (hipGetDevice(&dev) != hipSuccess || hipDeviceGetAttribute(&cus, hipDeviceAttributeMultiprocessorCount, dev) != hipSuccess) { grid = -1; return; }
        if (hipFuncSetAttribute((const void*)hybrid_fwd, hipFuncAttributeMaxDynamicSharedMemorySize, LDS_BYTES) != hipSuccess) { grid = -1; return; }
        int per_cu = 0;
        if (hipOccupancyMaxActiveBlocksPerMultiprocessor(&per_cu, (const void*)hybrid_fwd, NTHR, LDS_BYTES) != hipSuccess || per_cu < 1) fprintf(stderr, "kernel_launch: occupancy query says %d\n", per_cu);
        (void)hipGetLastError();
        grid = cus;
    }
    if (grid < 0) return;
    if (hipMemsetAsync((char*)d_ws + WS_CTL, 0, CTL_ZERO_BYTES, stream) != hipSuccess) return;
    Args a{};
    for (int i = 0; i < 21; ++i) a.in[i] = (const float*)d_in[i];
    a.out = (float*)d_out; a.ws = (unsigned char*)d_ws; a.ph_lo = 0; a.ph_hi = 12;
    hipLaunchKernelGGL(hybrid_fwd, dim3(grid), dim3(NTHR), LDS_BYTES, stream, a);
}
```

```cpp
#include <hip/hip_runtime.h>
#include <cstdio>
#include <cstdint>
#define PROBE 0
#define PROBE_LDS_WORD(k) ((volatile __attribute__((address_space(3))) unsigned*)(lds + (163840 - 512 + 320)) + 16 + (k))
__device__ __forceinline__ int hw_lane() { unsigned z = 0u; asm volatile("" : "+v"(z)); return (int)__builtin_amdgcn_mbcnt_hi(~0u, __builtin_amdgcn_mbcnt_lo(~0u, z)); }
__device__ __forceinline__ int shfl_idx_i(int v, int src) { return __builtin_amdgcn_ds_bpermute(src << 2, v); }
__device__ __forceinline__ int   my_shfl_xor(int v, int m)   { return shfl_idx_i(v, hw_lane() ^ m); }
__device__ __forceinline__ unsigned my_shfl_xor(unsigned v, int m) { return (unsigned)shfl_idx_i((int)v, hw_lane() ^ m); }
__device__ __forceinline__ float my_shfl_xor(float v, int m) { return __builtin_bit_cast(float, shfl_idx_i(__builtin_bit_cast(int, v), hw_lane() ^ m)); }
__device__ __forceinline__ int   my_shfl(int v, int src)     { return shfl_idx_i(v, src & 63); }
__device__ __forceinline__ unsigned my_shfl(unsigned v, int src) { return (unsigned)shfl_idx_i((int)v, src & 63); }
__device__ __forceinline__ float my_shfl(float v, int src)   { return __builtin_bit_cast(float, shfl_idx_i(__builtin_bit_cast(int, v), src & 63)); }
__device__ __forceinline__ int   my_shfl_up(int v, int d)    { const int l = hw_lane(); return shfl_idx_i(v, l - d < 0 ? l : l - d); }
__device__ __forceinline__ unsigned my_shfl_up(unsigned v, int d) { const int l = hw_lane(); return (unsigned)shfl_idx_i((int)v, l - d < 0 ? l : l - d); }
__device__ __forceinline__ float my_shfl_up(float v, int d)  { const int l = hw_lane(); return __builtin_bit_cast(float, shfl_idx_i(__builtin_bit_cast(int, v), l - d < 0 ? l : l - d)); }
#define __shfl_xor my_shfl_xor
#define __shfl_up my_shfl_up
#define __shfl my_shfl
namespace pg8 {
#define PG8_LAS __attribute__((address_space(3)))
typedef unsigned short bf16_t;
typedef short bf16x8 __attribute__((ext_vector_type(8)));
typedef float f32x4 __attribute__((ext_vector_type(4)));
typedef unsigned u32x4 __attribute__((ext_vector_type(4)));
constexpr int BM = 256, BK = 64, HALF = 128, HTB = HALF * BK * 2  , STAGE_BYTES = 8 * HTB, NXCD = 8, WGM = 8;

__host__ __device__ __forceinline__ int lds_byte(int r, int c) { const int st = (r >> 4) * 2 + (c >> 5), rr = r & 15, cc = c & 31, ob = rr * 64 + cc * 2; return st * 1024 + (ob ^ (((ob >> 9) & 1) << 5)); }
__host__ __device__ __forceinline__ void stage_rc(int b, int& R, int& C) { const int st = b / 1024, sb = b % 1024, swz = sb ^ (((sb >> 9) & 1) << 5); R = (st >> 1) * 16 + swz / 64; C = (st & 1) * 32 + (swz % 64) / 2; }
__host__ __device__ __forceinline__ int perm32(int rho) { const int n = rho >> 4, i = rho & 15; return 8 * (i >> 2) + 4 * n + (i & 3); }

struct Unit { int pm, pn, kb; };
struct Gemm { const bf16_t* A; const bf16_t* Bt; int M, N, K, lda, ldb; };

struct StaticOrder {
    int nM, nN, nwg, G, c;
    __host__ __device__ void init(int M, int N, int G_, int c_) { nM = M / BM; nN = N / BM; nwg = nM * nN; G = G_; c = c_; }
    __host__ __device__ bool next(int i, Unit& u) const {
        const long L = (long)i * G + c; if (L >= nwg) return false;
        int wgid = (int)L; { const int q = nwg / NXCD, r = nwg % NXCD, xcd = wgid % NXCD, off = wgid / NXCD; wgid = (xcd < r ? xcd * (q + 1) : r * (q + 1) + (xcd - r) * q) + off; }
        const int nig = WGM * nN, gid = wgid / nig, fm = gid * WGM, gsz = (nM - fm) < WGM ? (nM - fm) : WGM;
        u.pm = fm + ((wgid % nig) % gsz); u.pn = (wgid % nig) / gsz; u.kb = 0; return true;
    }
    __device__ __forceinline__ void a_ready(const Unit&) const {}
    __device__ __forceinline__ void done(const Unit&) const {}
};

__device__ __forceinline__ unsigned cvt_pk_bf16(float lo, float hi) { unsigned r; asm volatile("v_cvt_pk_bf16_f32 %0, %1, %2" : "=v"(r) : "v"(lo), "v"(hi)); return r; }
__host__ __device__ __forceinline__ int tile_perm(int t) { return (t & ~255) + 128 * ((t >> 5) & 1) + 32 * ((t >> 6) & 3) + (t & 31); }
__device__ __forceinline__ void store_full_lines(bf16_t* tile_row0  , int ldc, int fr, int fq, const u32x4& p0, const u32x4& p1, bf16_t* halo_row0 = nullptr, int halo_ld = 0) {
    const bool lo = fr < 8; u32x4 send = lo ? p1 : p0, recv;
#pragma unroll
    for (int k = 0; k < 4; ++k) recv[k] = (unsigned)__shfl_xor((int)send[k], 8);
    const int colo = (lo ? 0 : 32) + 8 * fq, r8 = fr & 7;
    *(u32x4*)(tile_row0 + (size_t)r8 * ldc + colo) = lo ? p0 : recv;
    const u32x4 wB = lo ? recv : p1;
    *(u32x4*)(tile_row0 + (size_t)(8 + r8) * ldc + colo) = wB;
    if (halo_row0 != nullptr && r8 >= 5) *(u32x4*)(halo_row0 + (size_t)(r8 - 5) * halo_ld + colo) = wB;
}
__device__ __forceinline__ void full_lines_pair(int fr, const u32x4& p0, const u32x4& p1, u32x4& wA, u32x4& wB) {
    const bool lo = fr < 8; u32x4 send = lo ? p1 : p0, recv;
#pragma unroll
    for (int k = 0; k < 4; ++k) recv[k] = (unsigned)__shfl_xor((int)send[k], 8);
    wA = lo ? p0 : recv; wB = lo ? recv : p1;
}
struct EpiBf16 {
    static constexpr bool PERM = true, AFTER_DRAIN = false, KSCALE = false; static constexpr int NST = 16;
    bf16_t* O; int ldc;
    __device__ __forceinline__ void operator()(const f32x4 (&acc)[2][2][4][2], const Unit& u, int wr, int wc, int fr, int fq) const {
        asm volatile("" : "+v"(fr), "+v"(fq));
#pragma unroll
        for (int ai = 0; ai < 2; ++ai)
#pragma unroll
            for (int m = 0; m < 4; ++m) { u32x4 w[2];
#pragma unroll
                for (int bj = 0; bj < 2; ++bj) { const f32x4 v0 = acc[ai][bj][m][0], v1 = acc[ai][bj][m][1];
                    w[bj].x = cvt_pk_bf16(v0[0], v0[1]); w[bj].y = cvt_pk_bf16(v0[2], v0[3]); w[bj].z = cvt_pk_bf16(v1[0], v1[1]); w[bj].w = cvt_pk_bf16(v1[2], v1[3]); }
                store_full_lines(O + (size_t)(u.pm * BM + ai * HALF + wr * 64 + m * 16) * ldc + u.pn * BM + 64 * wc, ldc, fr, fq, w[0], w[1]); }
    }
    __device__ __forceinline__ int defer(const f32x4 (&acc)[2][2][4][2], const Unit& u, int wr, int wc, int fr, int fq, u32x4 (&dq)[8], char*& dbase, int& s1, int& s2, int& s4) const {
        asm volatile("" : "+v"(fr), "+v"(fq));
#pragma unroll
        for (int ai = 0; ai < 2; ++ai)
#pragma unroll
            for (int m = 0; m < 4; ++m) { u32x4 w[2];
#pragma unroll
                for (int bj = 0; bj < 2; ++bj) { const f32x4 v0 = acc[ai][bj][m][0], v1 = acc[ai][bj][m][1];
                    w[bj].x = cvt_pk_bf16(v0[0], v0[1]); w[bj].y = cvt_pk_bf16(v0[2], v0[3]); w[bj].z = cvt_pk_bf16(v1[0], v1[1]); w[bj].w = cvt_pk_bf16(v1[2], v1[3]); }
                if (ai == 0) store_full_lines(O + (size_t)(u.pm * BM + wr * 64 + m * 16) * ldc + u.pn * BM + 64 * wc, ldc, fr, fq, w[0], w[1]);
                else full_lines_pair(fr, w[0], w[1], dq[2 * m], dq[2 * m + 1]); }
        dbase = (char*)(O + (size_t)(u.pm * BM + HALF + wr * 64 + (fr & 7)) * ldc + u.pn * BM + 64 * wc + (fr < 8 ? 0 : 32) + 8 * fq);
        s1 = 16 * ldc; s2 = 32 * ldc; s4 = 64 * ldc; return 0;
    }
};
struct EpiBf16KS : EpiBf16 {
    static constexpr bool KSCALE = true;
    const float* grs;
    __device__ __forceinline__ void kscale(f32x4 (&acc)[2][2][4][2], const Unit& u, int wr, int fr, int seg) const {
        asm volatile("" : "+v"(fr));
#pragma unroll
        for (int ai = 0; ai < 2; ++ai)
#pragma unroll
            for (int m = 0; m < 4; ++m) { const float* p = grs + (size_t)(u.pm * BM + ai * HALF + wr * 64 + m * 16 + fr) * 2;
                const float r0 = __hip_atomic_load(p, __ATOMIC_RELAXED, __HIP_MEMORY_SCOPE_AGENT), r1 = __hip_atomic_load(p + 1, __ATOMIC_RELAXED, __HIP_MEMORY_SCOPE_AGENT);
                const float f = seg == 0 ? r0 / r1 : r1;
#pragma unroll
                for (int bj = 0; bj < 2; ++bj)
#pragma unroll
                    for (int n = 0; n < 2; ++n) acc[ai][bj][m][n] = acc[ai][bj][m][n] * f; }
    }
};
struct EpiProj {
    static constexpr bool PERM = true, AFTER_DRAIN = false, KSCALE = false; static constexpr int NST = 16;
    bf16_t* O; int ldc; const float* rot; bf16_t* halo;
    __device__ __forceinline__ void operator()(const f32x4 (&acc)[2][2][4][2], const Unit& u, int wr, int wc, int fr, int fq) const {
        asm volatile("" : "+v"(fr), "+v"(fq));
        const int row0 = u.pm * BM + wr * 64 + fr;
        if (u.pn >= 14 && u.pn < 22) {
            const int seg = (u.pn < 18) ? 3584 : 4608, tile = (u.pn < 18) ? u.pn - 14 : u.pn - 18;
            const int head = 2 * tile + (wc >> 1), j0 = (wc & 1) * 32 + 8 * fq;
            const float lgs = ((u.pn < 18) ? 1.f : -1.f) * log2f(1.0f - exp2f(-5.0f - (float)head));
            const int pos0 = row0 < 32768 ? (row0 & 16383) : 1024 + ((row0 - 32768) & 31);
            const float* cp = rot + (size_t)pos0 * 64 + j0; const float* sp = cp + 16384 * 64; const float* cd = rot + (size_t)16 * 64 + j0; const float* sd = cd + 16384 * 64;
            f32x4 c0 = *(const f32x4*)cp, c1 = *(const f32x4*)(cp + 4), s0 = *(const f32x4*)sp, s1 = *(const f32x4*)(sp + 4);
            const f32x4 dc0 = *(const f32x4*)cd, dc1 = *(const f32x4*)(cd + 4), ds0 = *(const f32x4*)sd, ds1 = *(const f32x4*)(sd + 4);
            auto emit = [&](int ai, int m, int row, float fac) {
                const f32x4 x1a = acc[ai][0][m][0], x1b = acc[ai][0][m][1], x2a = acc[ai][1][m][0], x2b = acc[ai][1][m][1];
                const f32x4 o1a = (x1a * c0 - x2a * s0) * fac, o1b = (x1b * c1 - x2b * s1) * fac, o2a = (x1a * s0 + x2a * c0) * fac, o2b = (x1b * s1 + x2b * c1) * fac;
                bf16_t* rowp = O + (size_t)row * ldc + seg + 128 * head + j0;
                u32x4 w; w.x = cvt_pk_bf16(o1a[0], o1a[1]); w.y = cvt_pk_bf16(o1a[2], o1a[3]); w.z = cvt_pk_bf16(o1b[0], o1b[1]); w.w = cvt_pk_bf16(o1b[2], o1b[3]);
                *(u32x4*)rowp = w;
                w.x = cvt_pk_bf16(o2a[0], o2a[1]); w.y = cvt_pk_bf16(o2a[2], o2a[3]); w.z = cvt_pk_bf16(o2b[0], o2b[1]); w.w = cvt_pk_bf16(o2b[2], o2b[3]);
                *(u32x4*)(rowp + 64) = w; };
            if (u.pm >= 128) {
#pragma unroll
                for (int ai = 0; ai < 2; ++ai)
#pragma unroll
                    for (int m = 0; m < 4; ++m) { const int row = row0 + ai * HALF + m * 16;
                        if (ai + m > 0) { const int pos = 1024 + ((row - 32768) & 31); const float* cq = rot + (size_t)pos * 64 + j0; const float* sq = cq + 16384 * 64;
                            c0 = *(const f32x4*)cq; c1 = *(const f32x4*)(cq + 4); s0 = *(const f32x4*)sq; s1 = *(const f32x4*)(sq + 4); }
                        emit(ai, m, row, 1.f); }
                return;
            }
#pragma unroll
            for (int ai = 0; ai < 2; ++ai)
#pragma unroll
                for (int m = 0; m < 4; ++m) { const int row = row0 + ai * HALF + m * 16;
                    if (ai == 1 && m == 0) {
#pragma unroll
                        for (int k = 0; k < 4; ++k) { const f32x4 t0 = c0 * dc0 - s0 * ds0, t1 = c1 * dc1 - s1 * ds1; s0 = s0 * dc0 + c0 * ds0; s1 = s1 * dc1 + c1 * ds1; c0 = t0; c1 = t1; } }
                    emit(ai, m, row, exp2f(lgs * (float)(row & 255)));
                    { const f32x4 t0 = c0 * dc0 - s0 * ds0, t1 = c1 * dc1 - s1 * ds1; s0 = s0 * dc0 + c0 * ds0; s1 = s1 * dc1 + c1 * ds1; c0 = t0; c1 = t1; } }
            return;
        }
        const bool hal = (u.pn >= 8 && u.pn < 14) && wr == 1;
#pragma unroll
        for (int ai = 0; ai < 2; ++ai)
#pragma unroll
            for (int m = 0; m < 4; ++m) { u32x4 w[2];
#pragma unroll
                for (int bj = 0; bj < 2; ++bj) { const f32x4 v0 = acc[ai][bj][m][0], v1 = acc[ai][bj][m][1];
                    w[bj].x = cvt_pk_bf16(v0[0], v0[1]); w[bj].y = cvt_pk_bf16(v0[2], v0[3]); w[bj].z = cvt_pk_bf16(v1[0], v1[1]); w[bj].w = cvt_pk_bf16(v1[2], v1[3]); }
                store_full_lines(O + (size_t)(u.pm * BM + ai * HALF + wr * 64 + m * 16) * ldc + u.pn * BM + 64 * wc, ldc, fr, fq, w[0], w[1],
                                 (ai == 1 && m == 3 && hal) ? halo + (size_t)(u.pm * 3) * 1536 + (u.pn * BM - 2048) + 64 * wc : nullptr, 1536); }
    }
    __device__ __forceinline__ int defer(const f32x4 (&acc)[2][2][4][2], const Unit& u, int wr, int wc, int fr, int fq, u32x4 (&dq)[8], char*& dbase, int& s1, int& s2, int& s4) const {
        asm volatile("" : "+v"(fr), "+v"(fq));
        const int row0 = u.pm * BM + wr * 64 + fr;
        if (u.pn >= 14 && u.pn < 22) {
            if (u.pm >= 128) { (*this)(acc, u, wr, wc, fr, fq); return 8; }
            const int seg = (u.pn < 18) ? 3584 : 4608, tile = (u.pn < 18) ? u.pn - 14 : u.pn - 18;
            const int head = 2 * tile + (wc >> 1), j0 = (wc & 1) * 32 + 8 * fq;
            const float lgs = ((u.pn < 18) ? 1.f : -1.f) * log2f(1.0f - exp2f(-5.0f - (float)head));
            const int pos0 = row0 & 16383;
            const float* cp = rot + (size_t)pos0 * 64 + j0; const float* sp = cp + 16384 * 64; const float* cd = rot + (size_t)16 * 64 + j0; const float* sd = cd + 16384 * 64;
            f32x4 c0 = *(const f32x4*)cp, c1 = *(const f32x4*)(cp + 4), s0 = *(const f32x4*)sp, s1v = *(const f32x4*)(sp + 4);
            const f32x4 dc0 = *(const f32x4*)cd, dc1 = *(const f32x4*)(cd + 4), ds0 = *(const f32x4*)sd, ds1 = *(const f32x4*)(sd + 4);
            bf16_t* rowp0 = O + (size_t)row0 * ldc + seg + 128 * head + j0;
#pragma unroll
            for (int ai = 0; ai < 2; ++ai)
#pragma unroll
                for (int m = 0; m < 4; ++m) { const int row = row0 + ai * HALF + m * 16;
                    if (ai == 1 && m == 0) {
#pragma unroll
                        for (int k = 0; k < 4; ++k) { const f32x4 t0 = c0 * dc0 - s0 * ds0, t1 = c1 * dc1 - s1v * ds1; s0 = s0 * dc0 + c0 * ds0; s1v = s1v * dc1 + c1 * ds1; c0 = t0; c1 = t1; } }
                    const float fac = exp2f(lgs * (float)(row & 255));
                    const f32x4 x1a = acc[ai][0][m][0], x1b = acc[ai][0][m][1], x2a = acc[ai][1][m][0], x2b = acc[ai][1][m][1];
                    const f32x4 o1a = (x1a * c0 - x2a * s0) * fac, o1b = (x1b * c1 - x2b * s1v) * fac, o2a = (x1a * s0 + x2a * c0) * fac, o2b = (x1b * s1v + x2b * c1) * fac;
                    u32x4 wa, wb; wa.x = cvt_pk_bf16(o1a[0], o1a[1]); wa.y = cvt_pk_bf16(o1a[2], o1a[3]); wa.z = cvt_pk_bf16(o1b[0], o1b[1]); wa.w = cvt_pk_bf16(o1b[2], o1b[3]);
                    wb.x = cvt_pk_bf16(o2a[0], o2a[1]); wb.y = cvt_pk_bf16(o2a[2], o2a[3]); wb.z = cvt_pk_bf16(o2b[0], o2b[1]); wb.w = cvt_pk_bf16(o2b[2], o2b[3]);
                    if (ai == 0) { bf16_t* rowp = rowp0 + (size_t)(m * 16) * ldc; *(u32x4*)rowp = wa; *(u32x4*)(rowp + 64) = wb; }
                    else { dq[2 * m] = wa; dq[2 * m + 1] = wb; }
                    { const f32x4 t0 = c0 * dc0 - s0 * ds0, t1 = c1 * dc1 - s1v * ds1; s0 = s0 * dc0 + c0 * ds0; s1v = s1v * dc1 + c1 * ds1; c0 = t0; c1 = t1; } }
            dbase = (char*)(rowp0 + (size_t)HALF * ldc);
            s1 = 128; s2 = 32 * ldc; s4 = 64 * ldc; return 0;
        }
        const bool hal = (u.pn >= 8 && u.pn < 14) && wr == 1;
        const int colo = (fr < 8 ? 0 : 32) + 8 * fq, r8 = fr & 7;
#pragma unroll
        for (int ai = 0; ai < 2; ++ai)
#pragma unroll
            for (int m = 0; m < 4; ++m) { u32x4 w[2];
#pragma unroll
                for (int bj = 0; bj < 2; ++bj) { const f32x4 v0 = acc[ai][bj][m][0], v1 = acc[ai][bj][m][1];
                    w[bj].x = cvt_pk_bf16(v0[0], v0[1]); w[bj].y = cvt_pk_bf16(v0[2], v0[3]); w[bj].z = cvt_pk_bf16(v1[0], v1[1]); w[bj].w = cvt_pk_bf16(v1[2], v1[3]); }
                if (ai == 0) store_full_lines(O + (size_t)(u.pm * BM + wr * 64 + m * 16) * ldc + u.pn * BM + 64 * wc, ldc, fr, fq, w[0], w[1]);
                else full_lines_pair(fr, w[0], w[1], dq[2 * m], dq[2 * m + 1]); }
        if (hal && r8 >= 5) *(u32x4*)(halo + (size_t)(u.pm * 3 + (r8 - 5)) * 1536 + (u.pn * BM - 2048) + 64 * wc + colo) = dq[7];
        dbase = (char*)(O + (size_t)(u.pm * BM + HALF + wr * 64 + r8) * ldc + u.pn * BM + 64 * wc + colo);
        s1 = 16 * ldc; s2 = 32 * ldc; s4 = 64 * ldc; return 0;
    }
};
struct EpiF32 {
    static constexpr bool PERM = false, AFTER_DRAIN = false, KSCALE = false;
    float* C; int ldc;
    __device__ __forceinline__ void operator()(const f32x4 (&acc)[2][2][4][2], const Unit& u, int wr, int wc, int fr, int fq) const {
        const int row0 = u.pm * BM + wr * 64 + fr, col0 = u.pn * BM + wc * 32 + 4 * fq;
#pragma unroll
        for (int ai = 0; ai < 2; ++ai)
#pragma unroll
            for (int m = 0; m < 4; ++m) { float* rowp = C + (size_t)(row0 + ai * HALF + m * 16) * ldc + col0;
#pragma unroll
                for (int bj = 0; bj < 2; ++bj)
#pragma unroll
                    for (int n = 0; n < 2; ++n) *(f32x4*)(rowp + bj * HALF + n * 16) = acc[ai][bj][m][n]; }
    }
};
__device__ __forceinline__ float silu_f(float x) { return x * __builtin_amdgcn_rcpf(1.0f + __builtin_amdgcn_exp2f(-1.4426950408889634f * x)); }
struct EpiSwiGLU {
    static constexpr bool PERM = true, AFTER_DRAIN = false, KSCALE = false; static constexpr int NST = 8;
    bf16_t* O; int ldc; const float* rs2;
    __device__ __forceinline__ void operator()(const f32x4 (&acc)[2][2][4][2], const Unit& u, int wr, int wc, int fr, int fq) const {
        asm volatile("" : "+v"(fr), "+v"(fq));
        const int row0 = u.pm * BM + wr * 64 + fr; const int col0 = u.pn * HALF + wc * 32 + 8 * fq;
        float rsv[2][4];
#pragma unroll
        for (int ai = 0; ai < 2; ++ai)
#pragma unroll
            for (int m = 0; m < 4; ++m) rsv[ai][m] = __hip_atomic_load(rs2 + row0 + ai * HALF + m * 16, __ATOMIC_RELAXED, __HIP_MEMORY_SCOPE_AGENT);
#pragma unroll
        for (int ai = 0; ai < 2; ++ai)
#pragma unroll
            for (int m = 0; m < 4; ++m) { bf16_t* rowp = O + (size_t)(row0 + ai * HALF + m * 16) * ldc + col0; const float rs = rsv[ai][m];
                const f32x4 g0 = acc[ai][0][m][0] * rs, g1 = acc[ai][0][m][1] * rs, u0 = acc[ai][1][m][0] * rs, u1 = acc[ai][1][m][1] * rs;
                u32x4 w; w.x = cvt_pk_bf16(silu_f(g0[0]) * u0[0], silu_f(g0[1]) * u0[1]); w.y = cvt_pk_bf16(silu_f(g0[2]) * u0[2], silu_f(g0[3]) * u0[3]);
                w.z = cvt_pk_bf16(silu_f(g1[0]) * u1[0], silu_f(g1[1]) * u1[1]); w.w = cvt_pk_bf16(silu_f(g1[2]) * u1[2], silu_f(g1[3]) * u1[3]);
                *(u32x4*)rowp = w; }
    }
    __device__ __forceinline__ int defer(const f32x4 (&acc)[2][2][4][2], const Unit& u, int wr, int wc, int fr, int fq, u32x4 (&dq)[8], char*& dbase, int& s1, int& s2, int& s4) const {
        asm volatile("" : "+v"(fr), "+v"(fq));
        const int row0 = u.pm * BM + wr * 64 + fr; const int col0 = u.pn * HALF + wc * 32 + 8 * fq;
        float rsv[2][4];
#pragma unroll
        for (int ai = 0; ai < 2; ++ai)
#pragma unroll
            for (int m = 0; m < 4; ++m) rsv[ai][m] = __hip_atomic_load(rs2 + row0 + ai * HALF + m * 16, __ATOMIC_RELAXED, __HIP_MEMORY_SCOPE_AGENT);
#pragma unroll
        for (int ai = 0; ai < 2; ++ai)
#pragma unroll
            for (int m = 0; m < 4; ++m) { const float rs = rsv[ai][m];
                const f32x4 g0 = acc[ai][0][m][0] * rs, g1 = acc[ai][0][m][1] * rs, u0 = acc[ai][1][m][0] * rs, u1 = acc[ai][1][m][1] * rs;
                u32x4 w; w.x = cvt_pk_bf16(silu_f(g0[0]) * u0[0], silu_f(g0[1]) * u0[1]); w.y = cvt_pk_bf16(silu_f(g0[2]) * u0[2], silu_f(g0[3]) * u0[3]);
                w.z = cvt_pk_bf16(silu_f(g1[0]) * u1[0], silu_f(g1[1]) * u1[1]); w.w = cvt_pk_bf16(silu_f(g1[2]) * u1[2], silu_f(g1[3]) * u1[3]);
                dq[ai * 4 + m] = w; }
        dbase = (char*)(O + (size_t)row0 * ldc + col0);
        s1 = 32 * ldc; s2 = 64 * ldc; s4 = 256 * ldc; return 0;
    }
};

struct SampleSplitOrder {
    int c, kh, ns;
    __device__ __forceinline__ bool next(int i, Unit& u) const { if (i > 0 || c >= 16 * ns) return false; const int t = c / ns; u.pm = 128 + (t >> 2); u.pn = t & 3; u.kb = (c % ns) * kh; return true; }
    __device__ __forceinline__ void a_ready(const Unit&) const {}
    __device__ __forceinline__ void done(const Unit&) const {}
};
struct EpiSlab {
    static constexpr bool PERM = false, AFTER_DRAIN = false, KSCALE = false;
    float* C; int kh;
    __device__ __forceinline__ void operator()(const f32x4 (&acc)[2][2][4][2], const Unit& u, int wr, int wc, int fr, int fq) const {
        float* base = C + (size_t)(u.kb / kh) * 1024 * 1024;
        const int row0 = (u.pm - 128) * BM + wr * 64 + fr, col0 = u.pn * BM + wc * 64 + 4 * fq;
#pragma unroll
        for (int ai = 0; ai < 2; ++ai)
#pragma unroll
            for (int m = 0; m < 4; ++m) { float* rowp = base + (size_t)(row0 + ai * HALF + m * 16) * 1024 + col0;
#pragma unroll
                for (int bj = 0; bj < 2; ++bj)
#pragma unroll
                    for (int n = 0; n < 2; ++n) *(f32x4*)(rowp + bj * 32 + n * 16) = acc[ai][bj][m][n]; }
    }
};
struct EpiSlabB {
    static constexpr bool PERM = true, AFTER_DRAIN = false, KSCALE = false;
    bf16_t* C; int kh, ld; size_t slab_stride;
    __device__ __forceinline__ void operator()(const f32x4 (&acc)[2][2][4][2], const Unit& u, int wr, int wc, int fr, int fq) const {
        bf16_t* base = C + (size_t)(u.kb / kh) * slab_stride;
#pragma unroll
        for (int ai = 0; ai < 2; ++ai)
#pragma unroll
            for (int m = 0; m < 4; ++m) { u32x4 w[2];
#pragma unroll
                for (int bj = 0; bj < 2; ++bj) { const f32x4 v0 = acc[ai][bj][m][0], v1 = acc[ai][bj][m][1];
                    w[bj].x = cvt_pk_bf16(v0[0], v0[1]); w[bj].y = cvt_pk_bf16(v0[2], v0[3]); w[bj].z = cvt_pk_bf16(v1[0], v1[1]); w[bj].w = cvt_pk_bf16(v1[2], v1[3]); }
                store_full_lines(base + (size_t)((u.pm - 128) * BM + ai * HALF + wr * 64 + m * 16) * ld + u.pn * BM + 64 * wc, ld, fr, fq, w[0], w[1]); }
    }
};
template <class Epi, class Sched, bool ALIGN_EPI = false, bool SP2 = false, bool DEFER = false, bool RLX = false>
__device__ __forceinline__ void gemm_phase(PG8_LAS unsigned char* lds, const Gemm g, const Sched& S, const Epi& E, int wave_id) {
    int tid = wave_id * 64 + hw_lane(); asm volatile("" : "+v"(tid));
    const int wid = __builtin_amdgcn_readfirstlane(tid >> 6), lane = tid & 63, wr = wid >> 2, wc = wid & 3, fr = lane & 15, fq = lane >> 4;
    const int K = g.K, nt = K / BK;
    unsigned voffA[2], voffB[2];
#pragma unroll
    for (int i = 0; i < 2; ++i) { int R, C; stage_rc(tid * 16 + i * 8192, R, C); const int Rb = Epi::PERM ? ((R & ~31) + perm32(R & 31)) : R;
        voffA[i] = (unsigned)(R * g.lda + C) * 2u; voffB[i] = (unsigned)(Rb * g.ldb + C) * 2u; }
    const size_t kstep = (size_t)(BK * 2);
    const size_t hstepA = (size_t)HALF * g.lda * 2, hstepB = (size_t)HALF * g.ldb * 2;
    const size_t tstepA = 2 * hstepA, tstepB = 2 * hstepB;
    const unsigned ldsw = (unsigned)wid * 1024u;
    const int aoff = lds_byte(wr * 64 + fr, fq * 8), boff = lds_byte(wc * 32 + fr, fq * 8);
#define PG8_SA(b, h) (((b) * 2 + (h)) * HTB)
#define PG8_SB(b, h) ((4 + (b) * 2 + (h)) * HTB)
#define PG8_STAGE(bufoff, gbase, voff) do { const char* gb_ = (const char*)(gbase); asm volatile("" : "+s"(gb_)); _Pragma("unroll") for (int _i = 0; _i < 2; ++_i) { unsigned vo_ = (voff)[_i]; asm volatile("" : "+v"(vo_));     \
        __builtin_amdgcn_global_load_lds((const unsigned*)(gb_ + vo_), (PG8_LAS unsigned*)(lds + (bufoff) + ldsw + _i * 8192), 16, 0, 0); } } while (0)
#define PG8_LDA(dst, b, h) do { _Pragma("unroll") for (int m = 0; m < 4; ++m) _Pragma("unroll") for (int k = 0; k < 2; ++k) dst[m][k] = *(const PG8_LAS bf16x8*)(lds + PG8_SA(b, h) + aoff + m * 2048 + k * 1024); } while (0)
#define PG8_LDB(dst, b, h) do { _Pragma("unroll") for (int n = 0; n < 2; ++n) _Pragma("unroll") for (int k = 0; k < 2; ++k) dst[n][k] = *(const PG8_LAS bf16x8*)(lds + PG8_SB(b, h) + boff + n * 2048 + k * 1024); } while (0)
#define PG8_MMA(ai, bj, At, Bt) do { __builtin_amdgcn_s_setprio(1); _Pragma("unroll") for (int m = 0; m < 4; ++m) _Pragma("unroll") for (int n = 0; n < 2; ++n) _Pragma("unroll") for (int k = 0; k < 2; ++k) \
        acc[ai][bj][m][n] = __builtin_amdgcn_mfma_f32_16x16x32_bf16(Bt[n][k], At[m][k], acc[ai][bj][m][n], 0, 0, 0); __builtin_amdgcn_s_setprio(0); } while (0)
#define PG8_WAIT_V(n) asm volatile("s_waitcnt vmcnt(" #n ")" ::: "memory")
#define PG8_WAIT_L(n) asm volatile("s_waitcnt lgkmcnt(" #n ")" ::: "memory")
#define PG8_BAR __builtin_amdgcn_s_barrier()
#define PG8_SCHED __builtin_amdgcn_sched_barrier(0)
    Unit cur, nxt; int ui = 0;
    if (!S.next(0, cur)) return;
    u32x4 dq[8]; char* dbase = nullptr; int ds1 = 0, ds2 = 0, ds4 = 0, dpend = 8;
    if constexpr (DEFER) {
#pragma unroll
        for (int j = 0; j < 8; ++j) dq[j] = (u32x4){0u, 0u, 0u, 0u}; }
#define PG8_DEFER_ONE() do { u32x4* p_ = (u32x4*)(dbase + ((dpend & 1) * ds1 + ((dpend >> 1) & 1) * ds2 + (dpend >> 2) * ds4)); \
        if (dpend == 0) *p_ = dq[0]; else if (dpend == 1) *p_ = dq[1]; else if (dpend == 2) *p_ = dq[2]; else if (dpend == 3) *p_ = dq[3]; \
        else if (dpend == 4) *p_ = dq[4]; else if (dpend == 5) *p_ = dq[5]; else if (dpend == 6) *p_ = dq[6]; else *p_ = dq[7]; ++dpend; } while (0)
    f32x4 acc[2][2][4][2];
#pragma unroll
    for (int a = 0; a < 2; ++a)
#pragma unroll
        for (int b = 0; b < 2; ++b)
#pragma unroll
            for (int m = 0; m < 4; ++m)
#pragma unroll
                for (int n = 0; n < 2; ++n) acc[a][b][m][n] = (f32x4){0.f, 0.f, 0.f, 0.f};
    bf16x8 At[4][2], B0[2][2], B1[2][2];
    const char* cA = (const char*)g.A + (size_t)cur.pm * tstepA + (size_t)cur.kb * (BK * 2); const char* cB = (const char*)g.Bt + (size_t)cur.pn * tstepB + (size_t)cur.kb * (BK * 2);
    S.a_ready(cur);
    if constexpr (SP2) {
        PG8_STAGE(PG8_SB(0, 0), cB, voffB); PG8_STAGE(PG8_SB(0, 1), cB + hstepB, voffB); PG8_STAGE(PG8_SA(0, 0), cA, voffA); PG8_STAGE(PG8_SA(0, 1), cA + hstepA, voffA);
        if (wr == 1) PG8_BAR;
        PG8_WAIT_V(2); PG8_BAR;
        PG8_STAGE(PG8_SB(1, 0), cB + kstep, voffB); PG8_STAGE(PG8_SA(1, 0), cA + kstep, voffA); PG8_STAGE(PG8_SB(1, 1), cB + hstepB + kstep, voffB);
        PG8_WAIT_V(6); PG8_BAR;
    } else {
        PG8_STAGE(PG8_SB(0, 0), cB, voffB); PG8_STAGE(PG8_SA(0, 0), cA, voffA); PG8_STAGE(PG8_SB(0, 1), cB + hstepB, voffB); PG8_STAGE(PG8_SA(0, 1), cA + hstepA, voffA);
        if (wr == 1) PG8_BAR;
        PG8_WAIT_V(4); PG8_BAR;
        PG8_STAGE(PG8_SB(1, 0), cB + kstep, voffB); PG8_STAGE(PG8_SA(1, 0), cA + kstep, voffA); PG8_STAGE(PG8_SB(1, 1), cB + hstepB + kstep, voffB);
        PG8_WAIT_V(6); PG8_BAR;
    }
    const bool pr_ = PROBE && blockIdx.x == 0 && wid == 0 && g.N == 6912;
    unsigned acck_ = 0;
    for (;;) {
        unsigned pt0_ = 0; if (pr_) pt0_ = (unsigned)__builtin_amdgcn_s_memrealtime();
        const bool has_next = S.next(ui + 1, nxt);
        const char* nA = has_next ? (const char*)g.A + (size_t)nxt.pm * tstepA + (size_t)nxt.kb * (BK * 2) : cA; const char* nB = has_next ? (const char*)g.Bt + (size_t)nxt.pn * tstepB + (size_t)nxt.kb * (BK * 2) : cB;
        for (int t = 0; t < nt; t += 2) {
            const bool last = (t == nt - 2);
            const char* a1 = cA + (size_t)(t + 1) * kstep;
            const char* a2 = last ? nA : cA + (size_t)(t + 2) * kstep; const char* b2 = last ? nB : cB + (size_t)(t + 2) * kstep;
            const char* a3 = a2 + kstep; const char* b3 = b2 + kstep;
            if (last && has_next) S.a_ready(nxt);
            if constexpr (Epi::KSCALE) { if (t == 8 || t == 16) E.kscale(acc, cur, wr, fr, t == 8 ? 0 : 1); }
            if constexpr (SP2) {
#define PG8_WAIT_V89() do { if (st_) PG8_WAIT_V(9); else if (rlx_) { if constexpr (RLX) asm volatile("s_waitcnt vmcnt(%0)" :: "n"(8 + Epi::NST) : "memory"); } else PG8_WAIT_V(8); } while (0)
            const bool st_ = DEFER && dpend < 8; const bool rlx_ = RLX && t == 0 && ui > 0;
            PG8_LDB(B0, 0, 0); PG8_LDB(B1, 0, 1); PG8_SCHED; PG8_LDA(At, 0, 0); if (!rlx_) PG8_STAGE(PG8_SA(1, 1), a1 + hstepA, voffA); if constexpr (DEFER) { if (st_) PG8_DEFER_ONE(); }
            PG8_WAIT_V89(); PG8_WAIT_L(0); PG8_BAR; PG8_MMA(0, 0, At, B0); PG8_MMA(0, 1, At, B1); PG8_BAR; PG8_SCHED;
            PG8_LDA(At, 0, 1); PG8_STAGE(PG8_SB(0, 0), b2, voffB); PG8_STAGE(PG8_SB(0, 1), b2 + hstepB, voffB); PG8_STAGE(PG8_SA(0, 0), a2, voffA);
            PG8_WAIT_V89(); PG8_WAIT_L(0); PG8_BAR; PG8_MMA(1, 0, At, B0); PG8_MMA(1, 1, At, B1); PG8_BAR; PG8_SCHED;
            PG8_LDB(B0, 1, 0); PG8_LDB(B1, 1, 1); PG8_SCHED; PG8_LDA(At, 1, 0); PG8_STAGE(PG8_SA(0, 1), a2 + hstepA, voffA);
            PG8_WAIT_V89(); PG8_WAIT_L(0); PG8_BAR; PG8_MMA(0, 0, At, B0); PG8_MMA(0, 1, At, B1); PG8_BAR; PG8_SCHED;
            PG8_LDA(At, 1, 1); PG8_STAGE(PG8_SB(1, 0), b3, voffB); PG8_STAGE(PG8_SB(1, 1), b3 + hstepB, voffB); PG8_STAGE(PG8_SA(1, 0), a3, voffA);
            PG8_WAIT_V(8); PG8_WAIT_L(0); PG8_BAR; PG8_MMA(1, 0, At, B0); PG8_MMA(1, 1, At, B1); PG8_BAR; PG8_SCHED;
#undef PG8_WAIT_V89
            } else {
            PG8_LDB(B0, 0, 0); PG8_SCHED; PG8_LDA(At, 0, 0); PG8_STAGE(PG8_SA(1, 1), a1 + hstepA, voffA);
            PG8_WAIT_L(8); PG8_BAR; PG8_WAIT_L(0); PG8_MMA(0, 0, At, B0); PG8_BAR; PG8_SCHED;
            PG8_LDB(B1, 0, 1); PG8_STAGE(PG8_SB(0, 0), b2, voffB);
            PG8_BAR; PG8_WAIT_L(0); PG8_MMA(0, 1, At, B1); PG8_BAR;
            PG8_LDA(At, 0, 1); PG8_STAGE(PG8_SA(0, 0), a2, voffA);
            PG8_BAR; PG8_WAIT_L(0); PG8_MMA(1, 0, At, B0); PG8_BAR; PG8_SCHED;
            PG8_STAGE(PG8_SB(0, 1), b2 + hstepB, voffB);
            PG8_WAIT_V(6); PG8_BAR; PG8_MMA(1, 1, At, B1); PG8_BAR;
            PG8_LDB(B0, 1, 0); PG8_SCHED; PG8_LDA(At, 1, 0); PG8_STAGE(PG8_SA(0, 1), a2 + hstepA, voffA);
            PG8_WAIT_L(8); PG8_BAR; PG8_WAIT_L(0); PG8_MMA(0, 0, At, B0); PG8_BAR; PG8_SCHED;
            PG8_LDB(B1, 1, 1); PG8_STAGE(PG8_SB(1, 0), b3, voffB);
            PG8_BAR; PG8_WAIT_L(0); PG8_MMA(0, 1, At, B1); PG8_BAR;
            PG8_LDA(At, 1, 1); PG8_STAGE(PG8_SA(1, 0), a3, voffA);
            PG8_BAR; PG8_WAIT_L(0); PG8_MMA(1, 0, At, B0); PG8_BAR; PG8_SCHED;
            PG8_STAGE(PG8_SB(1, 1), b3 + hstepB, voffB);
            PG8_WAIT_V(6); PG8_BAR; PG8_MMA(1, 1, At, B1); PG8_BAR;
            }
        }
        unsigned pt1_ = 0; if (pr_) { pt1_ = (unsigned)__builtin_amdgcn_s_memrealtime(); acck_ += pt1_ - pt0_; }
        if constexpr (RLX) PG8_STAGE(PG8_SA(1, 1), nA + kstep + hstepA, voffA);
        if constexpr (ALIGN_EPI) { if (wr == 0) PG8_BAR; }
        if constexpr (DEFER) { while (dpend < 8) PG8_DEFER_ONE(); dpend = E.defer(acc, cur, wr, wc, fr, fq, dq, dbase, ds1, ds2, ds4); S.done(cur); } else
        if constexpr (!Epi::AFTER_DRAIN) { E(acc, cur, wr, wc, fr, fq); S.done(cur); }
        if (!has_next) break;
#pragma unroll
        for (int a = 0; a < 2; ++a)
#pragma unroll
            for (int b = 0; b < 2; ++b)
#pragma unroll
                for (int m = 0; m < 4; ++m)
#pragma unroll
                    for (int n = 0; n < 2; ++n) acc[a][b][m][n] = (f32x4){0.f, 0.f, 0.f, 0.f};
        cur = nxt; cA = nA; cB = nB; ++ui;
        if constexpr (ALIGN_EPI) { if (wr == 1) PG8_BAR; }
    }
    if constexpr (DEFER) { while (dpend < 8) PG8_DEFER_ONE(); }
    if (pr_) { *PROBE_LDS_WORD(24) = acck_; }
    PG8_WAIT_V(0);
    if constexpr (!ALIGN_EPI) { if (wr == 0) PG8_BAR; }
    PG8_BAR;
    if constexpr (Epi::AFTER_DRAIN) { E.fused(acc, cur, wr, wc, fr, fq, lds, wid, lane); S.done(cur); }
#undef PG8_DEFER_ONE
#undef PG8_SA
#undef PG8_SB
#undef PG8_STAGE
#undef PG8_LDA
#undef PG8_LDB
#undef PG8_MMA
#undef PG8_WAIT_V
#undef PG8_WAIT_L
#undef PG8_BAR
#undef PG8_SCHED
}
}

#define GAS __attribute__((address_space(1)))
#define LAS __attribute__((address_space(3)))
typedef unsigned short bf16;
typedef unsigned v4u __attribute__((ext_vector_type(4)));
typedef float f32x4 __attribute__((ext_vector_type(4)));
typedef short bf16x8 __attribute__((ext_vector_type(8)));
typedef GAS unsigned gu32;
typedef GAS unsigned long long gu64;
#define RLX_AGENT __ATOMIC_RELAXED, __HIP_MEMORY_SCOPE_AGENT
#define LDS_WAIT() asm volatile("s_waitcnt lgkmcnt(0)" ::: "memory")
#define VM_WAIT() asm volatile("s_waitcnt vmcnt(0)" ::: "memory")
__device__ __forceinline__ unsigned long long rt() { return __builtin_amdgcn_s_memrealtime(); }
__device__ __forceinline__ unsigned f2bf(float f) { unsigned u = __builtin_bit_cast(unsigned, f); return (u + 0x7fffu + ((u >> 16) & 1u)) >> 16; }
__device__ __forceinline__ unsigned pk2(float lo, float hi) { return f2bf(lo) | (f2bf(hi) << 16); }
__device__ __forceinline__ unsigned pkh(float lo, float hi) { typedef float f2_t __attribute__((ext_vector_type(2))); typedef __bf16 b2_t __attribute__((ext_vector_type(2))); f2_t v = {lo, hi}; b2_t b = __builtin_convertvector(v, b2_t); return __builtin_bit_cast(unsigned, b); }

#define XB_TMO      128
#define XB_XCNT(j)  (256  + 64 * (j))
#define XB_XSUB(j)  (1280 + 64 * (j))
#define XB_XGEN(j)  (2304 + 64 * (j))
#define XB_TOP      3328
#define XB_TOPGEN   3392
#define XCD_BAR_WORDS 3456
#define XB_SPIN_CAP (1u << 18)

__device__ __forceinline__ unsigned xb_ld(unsigned* p)              { return __hip_atomic_load(p, __ATOMIC_RELAXED, __HIP_MEMORY_SCOPE_AGENT); }
__device__ __forceinline__ unsigned xb_add(unsigned* p, unsigned v) { return __hip_atomic_fetch_add(p, v, __ATOMIC_RELAXED, __HIP_MEMORY_SCOPE_AGENT); }
__device__ __forceinline__ unsigned xb_xcc_id() { return (unsigned)__builtin_amdgcn_s_getreg((3 << 11) | 20) & 0xFu; }
#define XB_SPIN(cond, bar) do { unsigned _sp = 0; while (cond) { __builtin_amdgcn_s_sleep(1); \
    if ((++_sp & 255u) == 0u) { if (xb_ld(&(bar)[XB_TMO])) break; if (_sp > XB_SPIN_CAP) { atomicAdd(&(bar)[XB_TMO], 1u); break; } } } } while (0)

struct XcdBarrier {
    unsigned* bar; unsigned x; int wave;
    volatile LAS unsigned* st;
};

__device__ __forceinline__ XcdBarrier xcd_barrier_post(unsigned* bar, volatile LAS unsigned* st, int wave) {
    XcdBarrier b; b.bar = bar; b.x = xb_xcc_id(); b.st = st; b.wave = wave;
    if (wave == 0 && hw_lane() == 0) (void)xb_add(&bar[XB_XCNT(b.x)], 1u);
    return b;
}
__device__ __forceinline__ void xcd_barrier_complete(unsigned* bar, unsigned x, unsigned& nloc, unsigned& nx) {
    const unsigned G = gridDim.x * gridDim.y * gridDim.z;
    unsigned sum, cnt, mine, sp = 0u;
    for (;;) {
        sum = 0u; cnt = 0u; mine = 0u;
#pragma unroll
        for (unsigned j = 0; j < 16; ++j) { const unsigned c = xb_ld(&bar[XB_XCNT(j)]); sum += c; cnt += (c > 0u) ? 1u : 0u; mine = (j == x) ? c : mine; }
        if (sum == G) break;
        __builtin_amdgcn_s_sleep(1);
        if ((++sp & 255u) == 0u) { if (xb_ld(&bar[XB_TMO])) break; if (sp > XB_SPIN_CAP) { atomicAdd(&bar[XB_TMO], 1u); break; } }
    }
    nloc = mine > 0u ? mine : 1u; nx = cnt > 0u ? cnt : 1u;
}

__device__ __forceinline__ void xcd_barrier(const XcdBarrier& b) {
    asm volatile("s_waitcnt vmcnt(0)" ::: "memory");
    __syncthreads();
    if (b.wave == 0 && hw_lane() == 0) {
        unsigned* bar = b.bar;
        __builtin_amdgcn_s_waitcnt(0);
        unsigned nloc = b.st[0], nx = b.st[1];
        if (nloc == 0u) { xcd_barrier_complete(bar, b.x, nloc, nx); b.st[0] = nloc; b.st[1] = nx; }
        const unsigned old = xb_add(&bar[XB_XSUB(b.x)], 1u);
        const unsigned gen = old / nloc;
        if (old + 1u == (gen + 1u) * nloc) {
            __builtin_amdgcn_fence(__ATOMIC_RELEASE, "agent");
            asm volatile("s_waitcnt vmcnt(0)" ::: "memory");
            const unsigned og = xb_add(&bar[XB_TOP], 1u);
            const unsigned tg = og / nx;
            if (og + 1u == (tg + 1u) * nx) xb_add(&bar[XB_TOPGEN], 1u);
            else XB_SPIN(xb_ld(&bar[XB_TOPGEN]) == tg, bar);
            __builtin_amdgcn_fence(__ATOMIC_ACQUIRE, "agent");
            xb_add(&bar[XB_XGEN(b.x)], 1u);
            asm volatile("s_waitcnt vmcnt(0)" ::: "memory");
        } else {
            XB_SPIN(xb_ld(&bar[XB_XGEN(b.x)]) == gen, bar);
            __builtin_amdgcn_fence(__ATOMIC_ACQUIRE, "agent");
            asm volatile("s_waitcnt vmcnt(0)" ::: "memory");
        }
    }
    __syncthreads();
}


constexpr int PA_FROM = 30, PA_TO = 24, PB_FROM = 1, PB_TO = 2; constexpr float PA_DMAX = 400.f, PB_DMAX = 2000.f;
constexpr int NWAVES = 8, NTHR = 512;
constexpr int DM = 1024, PB = 2, PL = 16384, SBN = 32, SL = 32, PASTLEN = 1024;
constexpr int RP = PB * PL;
constexpr int RS = SBN * SL;
constexpr int RT = RP + RS;
constexpr int NPANEL = RT / 256, NPP = RP / 256;
constexpr int DSSM = 1024, NH = 16, HP = 64, NG = 2, NST = 128, CONVD = 1536;
constexpr int DRET = 1024, RH = 8, RD = 128;
constexpr int DFF = 2816, NIN = 6672;
constexpr int LP = 6912, Z0 = 0, G0 = 1024, XBC0 = 2048, XB0 = XBC0 + 1024, XC0 = XBC0 + 1280, Q0 = 3584, K0 = 4608, V0 = 5632, DT0 = 6656;
constexpr int X1_0 = 1024;
constexpr int HF0 = 2048;
constexpr int ACT0 = 3072;
constexpr int RAW2_0 = 3584;
constexpr size_t C_RAW2 = 0, C_SLAB2 = (size_t)32768 * 1024;
constexpr size_t C_X1 = 0, C_ACT = (size_t)33792 * 1024, C_RAW4 = C_ACT + (size_t)33792 * 2816, C_SLAB4 = C_RAW4 + (size_t)32768 * 1024;
static_assert((C_SLAB4 + (size_t)11 * 1024 * 1024) <= (size_t)33792 * 6912 && (C_SLAB2 + (size_t)4 * 1024 * 1024) * 2 <= (size_t)33792 * 1024 * 4, "compact buffers fit");
constexpr float EPS = 1e-6f;

constexpr size_t MiB = 1u << 20;
constexpr size_t WS_CTL = 0, CTL_ZERO_BYTES = 1 * MiB;
constexpr size_t WS_W1 = 1 * MiB;
constexpr size_t WS_W2 = 16 * MiB;
constexpr size_t WS_W3 = 20 * MiB;
constexpr size_t WS_W4 = 31 * MiB;
constexpr size_t WS_MISC = 37 * MiB;
constexpr size_t WS_PROJ = 48 * MiB;
constexpr size_t WS_ROT = WS_PROJ + (size_t)RT * LP * 2;
constexpr size_t WS_HALO = WS_ROT + (size_t)2 * PL * 64 * 4;
constexpr size_t WS_SLAB = (WS_HALO + (size_t)NPANEL * 3 * CONVD * 2 + 255) / 256 * 256;
constexpr size_t WS_END = WS_SLAB + (size_t)2 * RS * DM * 4;
static_assert(WS_END <= 512 * MiB && WS_ROT % 256 == 0 && WS_HALO % 256 == 0, "d_ws map");
constexpr size_t MS_SSQ = 0;
constexpr size_t MS_DEC = MS_SSQ + (size_t)RT * 16;
constexpr size_t MS_DT = MS_DEC + (size_t)NPP * 16;
constexpr size_t MS_ACUM = MS_DT + (size_t)RT * 16;
constexpr size_t MS_RS2 = MS_ACUM + (size_t)RT * 16;
constexpr size_t MS_GRS = MS_RS2 + (size_t)RT;
constexpr size_t MS_END = MS_GRS + (size_t)RP * 2;
static_assert(MS_END * 4 <= 11 * MiB, "misc map");
constexpr size_t O_YP = 0, O_YS = (size_t)RP * DM, O_CP = O_YS + (size_t)RS * DM, O_SP = O_CP + (size_t)PB * 3 * CONVD, O_RP = O_SP + (size_t)PB * NH * HP * NST,
                 O_CS = O_RP + (size_t)PB * RH * RD * RD, O_SS = O_CS + (size_t)SBN * 3 * CONVD, O_RS = O_SS + (size_t)SBN * NH * HP * NST, O_END = O_RS + (size_t)SBN * RH * RD * RD;
static_assert(O_END == 43672576, "d_out map");
constexpr size_t ST_SSD = 0;
constexpr size_t ST_RET = (size_t)NPP * NH * NST * HP;
static_assert((ST_RET + (size_t)NPP * RH * RD * RD) * 2 <= (size_t)RT * DM * 4, "state scratch fits the y region");

constexpr int CW_TMO = 0, CW_CODE = 1;
constexpr int CW_BAR = 4096;

constexpr int RING_OFF = 0, RING_BYTES = 131072;
constexpr int LDS_BYTES = 163840;
constexpr int LDSCTL_OFF = LDS_BYTES - 512, MISC_OFF = LDSCTL_OFF + 320;
constexpr int SCAN_LDS = LDSCTL_OFF;
static_assert(MISC_OFF + 128 <= LDS_BYTES, "LDS map");

struct Frame {
    LAS unsigned char* lds;
    volatile LAS unsigned* MISC;
    gu32* ctl;
    int tid, lane, wave;
    int vcu, G;
    const float *xp, *xs, *st_conv, *st_ssm, *st_ret, *n_mix_pre, *n_mix_post, *n_ffn_pre, *n_ffn_post, *w_in, *conv_w, *conv_b, *dt_bias, *a_log, *d_skip, *ssm_norm, *ret_norm, *w_out, *w_gate, *w_up, *w_down;
    float* out;
    bf16 *W1t, *W2t, *W3t, *W4t, *PROJ, *HB;
    float* misc; float* rot; bf16* halo; float* slab;
};
__device__ __forceinline__ float wave_sum(float v) {
#pragma unroll
    for (int o = 1; o < 64; o <<= 1) v += __shfl_xor(v, o);
    return v;
}
__device__ __forceinline__ const float* x_row(const Frame& F, int r) { return r < RP ? F.xp + (size_t)r * DM : F.xs + (size_t)(r - RP) * DM; }

__device__ const double ROT_REV[64] = {
0.15915494309189535, 0.13782250260398285, 0.11934937021124886, 0.10335229661843406,
0.08949940160889101, 0.07750328875537406, 0.06711508300522726, 0.058119267441876246,
0.050329212104487035, 0.04358330210530733, 0.03774158471741977, 0.032682865872357,
0.0283021958306234, 0.024508691862069852, 0.02122365276477766, 0.018378926105679667,
0.015915494309189534, 0.013782250260398284, 0.011934937021124886, 0.010335229661843406,
0.008949940160889102, 0.0077503288755374055, 0.006711508300522725, 0.005811926744187624,
0.005032921210448704, 0.004358330210530733, 0.003774158471741977, 0.0032682865872356993,
0.00283021958306234, 0.002450869186206985, 0.0021223652764777662, 0.0018378926105679667,
0.0015915494309189536, 0.0013782250260398288, 0.0011934937021124885, 0.0010335229661843405,
0.0008949940160889102, 0.0007750328875537405, 0.0006711508300522726, 0.0005811926744187624,
0.0005032921210448703, 0.0004358330210530733, 0.00037741584717419774, 0.0003268286587235699,
0.00028302195830623395, 0.00024508691862069854, 0.0002122365276477766, 0.00018378926105679666,
0.00015915494309189535, 0.00013782250260398286, 0.00011934937021124886, 0.00010335229661843406,
8.949940160889102e-05, 7.750328875537406e-05, 6.711508300522725e-05, 5.811926744187624e-05,
5.0329212104487035e-05, 4.358330210530732e-05, 3.774158471741978e-05, 3.2682865872357e-05,
2.8302195830623396e-05, 2.4508691862069852e-05, 2.122365276477766e-05, 1.8378926105679668e-05
};
__device__ __forceinline__ int dst_row(int mode, int n) {
    if (mode == 1) {
        int pos;
        if (n < 1024) pos = Z0 + n;
        else if (n < 2560) pos = XBC0 + (n - 1024);
        else if (n < 2576) pos = DT0 + (n - 2560);
        else if (n < 4624) { const int seg = (n < 3600) ? Q0 : K0, c = (n < 3600) ? n - 2576 : n - 3600, head = c >> 7, d = c & 127;
            return seg + 256 * (head >> 1) + 128 * (d >> 6) + 64 * (head & 1) + (d & 63); }
        else if (n < 5648) pos = V0 + (n - 4624);
        else pos = G0 + (n - 5648);
        return pg8::tile_perm(pos);
    }
    if (mode == 2) return 256 * (n >> 7) + (n & 127);
    if (mode == 3) return 256 * (n >> 7) + 128 + (n & 127);
    return pg8::tile_perm(n);
}
__device__ __forceinline__ void p0_transpose_item(const float* W, int K, int N, bf16* WT, int mode, const float* ks0, const float* ks1, int ksplit, LAS float* scr, int item, int lane) {
    const int nblk = (N + 31) / 32, kb = item / nblk, nb = item % nblk, k0 = 64 * kb, n0 = 32 * nb;
    const int c = lane & 7;
    float sc[8];
#pragma unroll
    for (int i = 0; i < 8; ++i) { const int k = k0 + 8 * c + i; sc[i] = ks0 ? (k < ksplit ? ks0[k] : ks1[k - ksplit]) : 1.f; }
    { const int q4 = 4 * (lane & 7); f32x4 v[8];
#pragma unroll
      for (int i = 0; i < 8; ++i) { const int kk = 8 * i + (lane >> 3); v[i] = (n0 + q4 < N) ? __builtin_nontemporal_load((const GAS f32x4*)(W + (size_t)(k0 + kk) * N + n0 + q4)) : (f32x4){0.f, 0.f, 0.f, 0.f}; }
#pragma unroll
      for (int i = 0; i < 8; ++i) { const int kk = 8 * i + (lane >> 3); LAS float* d = scr + kk * 33 + q4; d[0] = v[i][0]; d[1] = v[i][1]; d[2] = v[i][2]; d[3] = v[i][3]; } }
    LDS_WAIT(); asm volatile("" ::: "memory");
#pragma unroll
    for (int j = 0; j < 4; ++j) { const int n = (lane >> 3) + 8 * j; const LAS float* s = scr + (8 * c) * 33 + n;
        const float cs = (mode == 1 && n0 + n >= 3600 && n0 + n < 4624) ? 0.08838834764831845f : 1.f;
        v4u o; o.x = pk2(s[0 * 33] * sc[0] * cs, s[1 * 33] * sc[1] * cs); o.y = pk2(s[2 * 33] * sc[2] * cs, s[3 * 33] * sc[3] * cs); o.z = pk2(s[4 * 33] * sc[4] * cs, s[5 * 33] * sc[5] * cs); o.w = pk2(s[6 * 33] * sc[6] * cs, s[7 * 33] * sc[7] * cs);
        if (n0 + n < N) *(GAS v4u*)(WT + (size_t)dst_row(mode, n0 + n) * K + k0 + 8 * c) = o; }
    LDS_WAIT(); asm volatile("" ::: "memory");
}
__device__ __forceinline__ void rms_row_to_bf16(const Frame& F, const float* xrow, bf16* orow) {
    const GAS f32x4* xr = (const GAS f32x4*)xrow + F.lane;
    f32x4 v[4]; float s2 = 0.f;
#pragma unroll
    for (int j = 0; j < 4; ++j) { v[j] = xr[64 * j]; s2 += (v[j].x * v[j].x + v[j].y * v[j].y) + (v[j].z * v[j].z + v[j].w * v[j].w); }
    const float rs = 1.0f / sqrtf(wave_sum(s2) * (1.f / DM) + EPS);
    GAS unsigned long long* o8 = (GAS unsigned long long*)orow + F.lane;
#pragma unroll
    for (int j = 0; j < 4; ++j) o8[64 * j] = (unsigned long long)pk2(v[j].x * rs, v[j].y * rs) | ((unsigned long long)pk2(v[j].z * rs, v[j].w * rs) << 32);
}
__device__ __forceinline__ void p0_prologue(Frame& F) {
    LAS float* scr = (LAS float*)(F.lds + RING_OFF + F.wave * 16384);
    const int gw = F.vcu * NWAVES + F.wave, NGW = F.G * NWAVES;
    constexpr int I_1 = (DM / 64) * ((NIN + 31) / 32), I_2 = (2048 / 64) * (DM / 32), I_3 = (DM / 64) * (DFF / 32), I_4 = (DFF / 64) * (DM / 32);
    constexpr int NITEMS = I_1 + I_2;
    for (int it = gw; it < NITEMS; it += NGW) {
        int r = it;
        if (r < I_1) { p0_transpose_item(F.w_in, DM, NIN, F.W1t, 1, F.n_mix_pre, F.n_mix_pre, DM, scr, r, F.lane); continue; } r -= I_1;
        p0_transpose_item(F.w_out, 2048, DM, F.W2t, 0, F.ssm_norm, F.ret_norm, DSSM, scr, r, F.lane);
    }
    { GAS v4u* z = (GAS v4u*)(F.W1t + (size_t)(DT0 + 16) * DM); const int n16 = (LP - DT0 - 16) * DM * 2 / 16;
      for (int i = gw * 64 + F.lane; i < n16; i += NGW * 64) z[i] = (v4u){0u, 0u, 0u, 0u}; }
    for (int i = gw * 64 + F.lane; i < PL * 64; i += NGW * 64) { const int pos = i >> 6, j = i & 63;
        const double rev = (double)pos * ROT_REV[j]; const float fr = (float)(rev - __builtin_floor(rev));
        F.rot[i] = __builtin_amdgcn_cosf(fr); F.rot[PL * 64 + i] = __builtin_amdgcn_sinf(fr); }
    for (int m2 = (gw + 512) % NGW; m2 < RT / 2; m2 += NGW) { const int ma = 2 * m2, mb = ma + 1;
        const GAS f32x4* xa = (const GAS f32x4*)x_row(F, ma) + F.lane; const GAS f32x4* xb = (const GAS f32x4*)x_row(F, mb) + F.lane;
        f32x4 va[4], vb[4]; float sa = 0.f, sb = 0.f;
#pragma unroll
        for (int j = 0; j < 4; ++j) { va[j] = __builtin_nontemporal_load(xa + 64 * j); vb[j] = __builtin_nontemporal_load(xb + 64 * j); }
#pragma unroll
        for (int j = 0; j < 4; ++j) { sa += (va[j].x * va[j].x + va[j].y * va[j].y) + (va[j].z * va[j].z + va[j].w * va[j].w); sb += (vb[j].x * vb[j].x + vb[j].y * vb[j].y) + (vb[j].z * vb[j].z + vb[j].w * vb[j].w); }
#pragma unroll
        for (int o = 1; o < 64; o <<= 1) { sa += __shfl_xor(sa, o); sb += __shfl_xor(sb, o); }
        const float ra = 1.0f / sqrtf(sa * (1.f / DM) + EPS), rb = 1.0f / sqrtf(sb * (1.f / DM) + EPS);
        GAS unsigned long long* oa = (GAS unsigned long long*)(F.HB + (size_t)ma * DM) + F.lane; GAS unsigned long long* ob = (GAS unsigned long long*)(F.HB + (size_t)mb * DM) + F.lane;
#pragma unroll
        for (int j = 0; j < 4; ++j) { oa[64 * j] = (unsigned long long)pkh(va[j].x * ra, va[j].y * ra) | ((unsigned long long)pkh(va[j].z * ra, va[j].w * ra) << 32);
            ob[64 * j] = (unsigned long long)pkh(vb[j].x * rb, vb[j].y * rb) | ((unsigned long long)pkh(vb[j].z * rb, vb[j].w * rb) << 32); }
    }
}
__device__ __forceinline__ void late_weight_items(Frame& F, const int which, const int j, const int n) {
    LAS float* scr = (LAS float*)(F.lds + RING_OFF + F.wave * 16384); const int lane = hw_lane();
    constexpr int I_3 = (DM / 64) * (DFF / 32), I_4 = (DFF / 64) * (DM / 32);
    const int cnt = which == 0 ? 2 * I_3 : I_4;
    for (int it = j * NWAVES + F.wave; it < cnt; it += n * NWAVES) {
        if (which == 0) { if (it < I_3) p0_transpose_item(F.w_gate, DM, DFF, F.W3t, 2, F.n_ffn_pre, F.n_ffn_pre, DM, scr, it, lane); else p0_transpose_item(F.w_up, DM, DFF, F.W3t, 3, F.n_ffn_pre, F.n_ffn_pre, DM, scr, it - I_3, lane); }
        else p0_transpose_item(F.w_down, DFF, DM, F.W4t, 0, nullptr, nullptr, 0, scr, it, lane);
    }
}

typedef float f32x4v __attribute__((ext_vector_type(4)));
__device__ __forceinline__ float bf2f(unsigned short b) { return __builtin_bit_cast(float, (unsigned)b << 16); }
__device__ __forceinline__ float bflo(unsigned w) { return __builtin_bit_cast(float, w << 16); }
__device__ __forceinline__ float bfhi(unsigned w) { return __builtin_bit_cast(float, w & 0xffff0000u); }
__device__ __forceinline__ float silu(float x) { return x * __builtin_amdgcn_rcpf(1.0f + __expf(-x)); }
__device__ __forceinline__ void bar_sync() { __syncthreads(); }
__device__ __forceinline__ void lds_barrier() { asm volatile("s_waitcnt lgkmcnt(0)" ::: "memory"); __builtin_amdgcn_s_barrier(); asm volatile("" ::: "memory"); }
__device__ __forceinline__ f32x4 mma_tile(const LAS bf16* A, int pa, const LAS bf16* B, int pb, int K, f32x4 acc, int lane) {
    const int r = lane & 15, q = lane >> 4;
    const LAS bf16* ap = A + r * pa + 8 * q; const LAS bf16* bp = B + r * pb + 8 * q;
    for (int k0 = 0; k0 < K; k0 += 32) {
        const bf16x8 a = *(const LAS bf16x8*)(ap + k0), b = *(const LAS bf16x8*)(bp + k0);
        acc = __builtin_amdgcn_mfma_f32_16x16x32_bf16(a, b, acc, 0, 0, 0);
    }
    return acc;
}
struct SeqInfo { int r0; int tseq0; int pos0; int sb; };

__device__ __forceinline__ void conv_pair(const Frame& F, const SeqInfo& si, int t, int c, float& o0, float& o1) {
    const unsigned w = *(const GAS unsigned*)(F.PROJ + (size_t)(si.r0 + t) * LP + XBC0 + c); o0 = bflo(w); o1 = bfhi(w);
}
__device__ __forceinline__ float softplus_f(float x) { return fmaxf(x, 0.f) + log1pf(__expf(-fabsf(x))); }

constexpr int SP_A = 136, SP_T = 72;
constexpr int SS_CM = 0, SS_BM = SS_CM + 64 * SP_A * 2, SS_BT = SS_BM + 64 * SP_A * 2, SS_XT = SS_BT + 128 * SP_T * 2, SS_XW = SS_XT + 64 * SP_T * 2, SS_MM = SS_XW + 64 * SP_T * 2,
              SS_HB = SS_MM + 64 * SP_T * 2, SS_YT = SS_HB + 64 * SP_A * 2, SS_VEC = SS_YT + 64 * 65 * 4, SS_END = SS_VEC + 6 * 256 * 4;
static_assert(SS_END <= RING_BYTES, "ssd LDS map");

template <int T, int NCH, int MODE>
__device__ __forceinline__ void ssd_unit(Frame& F, const SeqInfo si, const int e, const int sidx) {
    LAS unsigned char* L = F.lds + RING_OFF;
    LAS bf16* Cm = (LAS bf16*)(L + SS_CM); LAS bf16* Bm = (LAS bf16*)(L + SS_BM); LAS bf16* Bt = (LAS bf16*)(L + SS_BT); LAS bf16* Xt = (LAS bf16*)(L + SS_XT);
    LAS bf16* Xw = (LAS bf16*)(L + SS_XW); LAS bf16* Mm = (LAS bf16*)(L + SS_MM); LAS bf16* Hb = (LAS bf16*)(L + SS_HB); LAS float* Yt = (LAS float*)(L + SS_YT);
    LAS float* dtv = (LAS float*)(L + SS_VEC); LAS float* acum = dtv + 256; LAS float* ea = acum + 256; LAS float* wv = ea + 256; LAS float* rowsq = wv + 256; LAS float* wtot = rowsq + 256;
    const int tid = F.tid, lane = F.lane, w = F.wave, r = lane & 15, q = lane >> 4;
    const int g = e >> 3;
    const float dsk = F.d_skip[e];
    constexpr int NROW = T * NCH, NT = T / 16;
    float dtl = 0.f, sc = 0.f;
    if (tid < NROW) { dtl = F.misc[MS_DT + (size_t)(si.r0 + tid) * 16 + e]; sc = F.misc[MS_ACUM + (size_t)(si.r0 + tid) * 16 + e]; dtv[tid] = dtl; acum[tid] = sc; }
    if (lane == 63) wtot[w] = sc;
    bar_sync();
    if (tid < NROW) {
        if (MODE == 0) { float off = 0.f, tot = 0.f;
#pragma unroll
            for (int i = 0; i < NROW / 64; ++i) { const float x = wtot[i]; tot += x; if (i < w) off += x; }
            wv[tid] = __expf(tot - (sc + off)) * dtl;
            if (tid == 0) F.misc[MS_DEC + (size_t)sidx * 16 + e] = __expf(tot);
        } else { const float last = acum[tid | (T - 1)]; ea[tid] = __expf(sc); wv[tid] = __expf(last - sc) * dtl; }
    }
    f32x4 hst[4];
#pragma unroll
    for (int pt = 0; pt < 4; ++pt) {
        if (MODE == 0) hst[pt] = (f32x4){0.f, 0.f, 0.f, 0.f};
        else if (MODE == 1) { const bf16* S = (const bf16*)F.out + ST_SSD + (size_t)(sidx * 16 + e) * 8192;
#pragma unroll
            for (int j = 0; j < 4; ++j) hst[pt][j] = bf2f(S[(size_t)(16 * pt + r) * 128 + 16 * w + 4 * q + j]); }
        else { const float* S = F.st_ssm + (size_t)(sidx * 16 + e) * 8192;
#pragma unroll
            for (int j = 0; j < 4; ++j) hst[pt][j] = S[(size_t)(16 * pt + r) * 128 + 16 * w + 4 * q + j]; }
        if (MODE != 0) { unsigned long long pk = (unsigned long long)pk2(hst[pt][0], hst[pt][1]) | ((unsigned long long)pk2(hst[pt][2], hst[pt][3]) << 32);
            *(LAS unsigned long long*)(Hb + (16 * pt + r) * SP_A + 16 * w + 4 * q) = pk; }
    }
    bar_sync();
    for (int c = 0; c < NCH; ++c) {
        const int tb = c * T;
        for (int idx = tid; idx < T * 32; idx += NTHR) { const int t = idx >> 5, c2 = (idx & 31) * 2; float o0, o1; conv_pair(F, si, tb + t, 64 * e + c2, o0, o1);
            const float ww = wv[tb + t];
            if (MODE != 0) { Xt[c2 * SP_T + t] = (bf16)f2bf(o0); Xt[(c2 + 1) * SP_T + t] = (bf16)f2bf(o1); }
            Xw[c2 * SP_T + t] = (bf16)f2bf(o0 * ww); Xw[(c2 + 1) * SP_T + t] = (bf16)f2bf(o1 * ww); }
        for (int idx = tid; idx < T * 64; idx += NTHR) { const int t = idx >> 6, n = (idx & 63) * 2; float o0, o1; conv_pair(F, si, tb + t, 1024 + 128 * g + n, o0, o1);
            if (MODE != 0) *(LAS unsigned*)(Bm + t * SP_A + n) = pk2(o0, o1);
            Bt[n * SP_T + t] = (bf16)f2bf(o0); Bt[(n + 1) * SP_T + t] = (bf16)f2bf(o1); }
        if (MODE != 0) for (int idx = tid; idx < T * 64; idx += NTHR) { const int t = idx >> 6, n = (idx & 63) * 2; float o0, o1; conv_pair(F, si, tb + t, 1280 + 128 * g + n, o0, o1);
            *(LAS unsigned*)(Cm + t * SP_A + n) = pk2(o0, o1); }
        bar_sync();
        if (MODE != 0) {
            for (int ti = w; ti < NT * NT; ti += NWAVES) { const int lt = ti / NT, st = ti % NT;
                f32x4 acc = mma_tile(Cm + 16 * lt * SP_A, SP_A, Bm + 16 * st * SP_A, SP_A, 128, (f32x4){0.f, 0.f, 0.f, 0.f}, lane);
                const int s = 16 * st + r; const float as = acum[tb + s], ds = dtv[tb + s];
#pragma unroll
                for (int j = 0; j < 4; ++j) { const int l = 16 * lt + 4 * q + j; const float m = (l >= s) ? acc[j] * __expf(acum[tb + l] - as) * ds : 0.f; Mm[l * SP_T + s] = (bf16)f2bf(m); } }
            bar_sync();
            for (int ti = w; ti < NT * 4; ti += NWAVES) { const int lt = ti >> 2, pt = ti & 3;
                f32x4 acc = mma_tile(Cm + 16 * lt * SP_A, SP_A, Hb + 16 * pt * SP_A, SP_A, 128, (f32x4){0.f, 0.f, 0.f, 0.f}, lane);
#pragma unroll
                for (int j = 0; j < 4; ++j) acc[j] *= ea[tb + 16 * lt + 4 * q + j];
                acc = mma_tile(Mm + 16 * lt * SP_T, SP_T, Xt + 16 * pt * SP_T, SP_T, T, acc, lane);
#pragma unroll
                for (int j = 0; j < 4; ++j) { const int l = 16 * lt + 4 * q + j; Yt[l * 65 + 16 * pt + r] = acc[j] + dsk * bf2f(Xt[(16 * pt + r) * SP_T + l]); } }
            bar_sync();
            for (int idx = tid; idx < T * 32; idx += NTHR) { const int l = idx >> 5, pp = idx & 31;
                GAS unsigned* zp = (GAS unsigned*)(F.PROJ + (size_t)(si.r0 + tb + l) * LP + Z0 + 64 * e + 2 * pp); const unsigned zw = *zp;
                const float y0 = Yt[l * 65 + 2 * pp] * silu(bflo(zw)), y1 = Yt[l * 65 + 2 * pp + 1] * silu(bfhi(zw));
                float ss = y0 * y0 + y1 * y1;
#pragma unroll
                for (int o = 1; o < 32; o <<= 1) ss += __shfl_xor(ss, o);
                if ((lane & 31) == 0) rowsq[tb + l] = ss;
                *zp = pk2(y0, y1); }
        }
        const float dch = (MODE == 0) ? 1.f : __expf(acum[tb + T - 1]);
#pragma unroll
        for (int pt = 0; pt < 4; ++pt) { hst[pt] = hst[pt] * dch; hst[pt] = mma_tile(Bt + 16 * w * SP_T, SP_T, Xw + 16 * pt * SP_T, SP_T, T, hst[pt], lane);
            if (MODE != 0) { unsigned long long pk = (unsigned long long)pk2(hst[pt][0], hst[pt][1]) | ((unsigned long long)pk2(hst[pt][2], hst[pt][3]) << 32);
                *(LAS unsigned long long*)(Hb + (16 * pt + r) * SP_A + 16 * w + 4 * q) = pk; } }
        bar_sync();
    }
    if (MODE == 0) { float* S = F.out + ST_SSD + ((size_t)(sidx * 16 + e) * 128) * 64;
#pragma unroll
        for (int pt = 0; pt < 4; ++pt)
#pragma unroll
            for (int j = 0; j < 4; ++j) S[(size_t)(16 * w + 4 * q + j) * 64 + 16 * pt + r] = hst[pt][j]; }
    if (MODE != 0) { if (tid < NROW) F.misc[MS_SSQ + (size_t)(si.r0 + tid) * 16 + e] = rowsq[tid]; }
    if (MODE == 2) { float* S = F.out + O_SS + (size_t)(sidx * 16 + e) * 8192;
#pragma unroll
        for (int pt = 0; pt < 4; ++pt)
#pragma unroll
            for (int j = 0; j < 4; ++j) S[(size_t)(16 * pt + r) * 128 + 16 * w + 4 * q + j] = hst[pt][j]; }
    bar_sync();
}

constexpr int RS_QM = 0, RS_KM = RS_QM + 64 * SP_A * 2, RS_KW = RS_KM + 64 * SP_A * 2, RS_VT = RS_KW + 128 * SP_T * 2, RS_PM = RS_VT + 128 * SP_T * 2, RS_ST = RS_PM + 64 * SP_T * 2,
              RS_VEC = RS_ST + 128 * SP_A * 2, RS_END = RS_VEC + 2 * 64 * 4 * 4;
static_assert(RS_END <= RING_BYTES, "retention LDS map");
template <int T, int NCH, int MODE>
__device__ __forceinline__ void ret_unit(Frame& F, const SeqInfo si, const int hh, const int sidx) {
    LAS unsigned char* L = F.lds + RING_OFF;
    LAS bf16* Qm = (LAS bf16*)(L + RS_QM); LAS bf16* Km = (LAS bf16*)(L + RS_KM); LAS bf16* Yb = Km; LAS bf16* Kw = (LAS bf16*)(L + RS_KW); LAS bf16* Vt = (LAS bf16*)(L + RS_VT);
    LAS bf16* Pm = (LAS bf16*)(L + RS_PM); LAS bf16* St = (LAS bf16*)(L + RS_ST); LAS float* part = (LAS float*)(L + RS_VEC); LAS float* part2 = part + 256;
    const int tid = F.tid, lane = F.lane, w = F.wave, r = lane & 15, q = lane >> 4;
    constexpr int NROW = T * NCH, NT = T / 16, NSH = 8 / NT;
    const float lg2 = log2f(1.0f - exp2f(-5.0f - (float)hh));
    f32x4 sst[8];
#pragma unroll
    for (int i = 0; i < 8; ++i) {
        if (MODE == 0) sst[i] = (f32x4){0.f, 0.f, 0.f, 0.f};
        else { if (MODE == 1) { const bf16* S = (const bf16*)F.out + ST_RET + (size_t)(sidx * 8 + hh) * 16384;
#pragma unroll
                for (int j = 0; j < 4; ++j) sst[i][j] = bf2f(S[(size_t)(16 * i + r) * 128 + 16 * w + 4 * q + j]); }
            else { const float* S = F.st_ret + (size_t)(sidx * 8 + hh) * 16384;
#pragma unroll
                for (int j = 0; j < 4; ++j) sst[i][j] = S[(size_t)(16 * w + 4 * q + j) * 128 + 16 * i + r]; }
            unsigned long long pk = (unsigned long long)pk2(sst[i][0], sst[i][1]) | ((unsigned long long)pk2(sst[i][2], sst[i][3]) << 32);
            *(LAS unsigned long long*)(St + (16 * i + r) * SP_A + 16 * w + 4 * q) = pk; }
    }
    for (int c = 0; c < NCH; ++c) {
        const int tb = c * T;
        for (int idx = tid; idx < T * 64; idx += NTHR) { const int t = idx >> 6, j2 = (idx & 63) * 2;
            const GAS bf16* row = (const GAS bf16*)(F.PROJ + (size_t)(si.r0 + tb + t) * LP);
            const unsigned kw2 = *(const GAS unsigned*)(row + K0 + 128 * hh + j2);
            const float kwt = exp2f(lg2 * (float)((MODE == 0 ? NROW - 1 - tb : T - 1) - t));
            Kw[j2 * SP_T + t] = (bf16)f2bf(bflo(kw2) * kwt); Kw[(j2 + 1) * SP_T + t] = (bf16)f2bf(bfhi(kw2) * kwt);
            if (MODE != 0) { *(LAS unsigned*)(Qm + t * SP_A + j2) = *(const GAS unsigned*)(row + Q0 + 128 * hh + j2); *(LAS unsigned*)(Km + t * SP_A + j2) = kw2; } }
        for (int idx = tid; idx < T * 64; idx += NTHR) { const int t = idx >> 6, e2 = (idx & 63) * 2;
            const unsigned vw = *(const GAS unsigned*)(F.PROJ + (size_t)(si.r0 + tb + t) * LP + V0 + 128 * hh + e2);
            Vt[e2 * SP_T + t] = (bf16)(vw & 0xffffu); Vt[(e2 + 1) * SP_T + t] = (bf16)(vw >> 16); }
        bar_sync();
        if (MODE != 0) {
            for (int ti = w; ti < NT * NT; ti += NWAVES) { const int lt = ti / NT, st = ti % NT;
                f32x4 acc = mma_tile(Qm + 16 * lt * SP_A, SP_A, Km + 16 * st * SP_A, SP_A, 128, (f32x4){0.f, 0.f, 0.f, 0.f}, lane);
                const int s = 16 * st + r;
#pragma unroll
                for (int j = 0; j < 4; ++j) { const int l = 16 * lt + 4 * q + j; const float m = (l >= s) ? acc[j] * exp2f(lg2 * (float)(l - s)) : 0.f; Pm[l * SP_T + s] = (bf16)f2bf(m); } }
            bar_sync();
            const int lt = w % NT, slot = w / NT;
            f32x4 acc[NT];
#pragma unroll
            for (int i = 0; i < NT; ++i) { const int et = slot * NT + i;
                acc[i] = mma_tile(Qm + 16 * lt * SP_A, SP_A, St + 16 * et * SP_A, SP_A, 128, (f32x4){0.f, 0.f, 0.f, 0.f}, lane);
#pragma unroll
                for (int j = 0; j < 4; ++j) acc[i][j] *= exp2f(lg2 * (float)(16 * lt + 4 * q + j + 1));
                acc[i] = mma_tile(Pm + 16 * lt * SP_T, SP_T, Vt + 16 * et * SP_T, SP_T, T, acc[i], lane); }
            float mean[4], rstd[4];
#pragma unroll
            for (int j = 0; j < 4; ++j) { float s = 0.f;
#pragma unroll
                for (int i = 0; i < NT; ++i) s += acc[i][j];
                s += __shfl_xor(s, 1); s += __shfl_xor(s, 2); s += __shfl_xor(s, 4); s += __shfl_xor(s, 8);
                if (r == 0) part[(16 * lt + 4 * q + j) * 4 + slot] = s; }
            bar_sync();
#pragma unroll
            for (int j = 0; j < 4; ++j) { float s = 0.f;
#pragma unroll
                for (int k = 0; k < NSH; ++k) s += part[(16 * lt + 4 * q + j) * 4 + k];
                mean[j] = s * (1.0f / 128.0f); float d2 = 0.f;
#pragma unroll
                for (int i = 0; i < NT; ++i) { const float d = acc[i][j] - mean[j]; d2 += d * d; }
                d2 += __shfl_xor(d2, 1); d2 += __shfl_xor(d2, 2); d2 += __shfl_xor(d2, 4); d2 += __shfl_xor(d2, 8);
                if (r == 0) part2[(16 * lt + 4 * q + j) * 4 + slot] = d2; }
            bar_sync();
#pragma unroll
            for (int j = 0; j < 4; ++j) { float s = 0.f;
#pragma unroll
                for (int k = 0; k < NSH; ++k) s += part2[(16 * lt + 4 * q + j) * 4 + k];
                rstd[j] = 1.0f / sqrtf(s * (1.0f / 128.0f) + EPS); }
#pragma unroll
            for (int i = 0; i < NT; ++i)
#pragma unroll
                for (int j = 0; j < 4; ++j) Yb[(16 * lt + 4 * q + j) * SP_A + 16 * (slot * NT + i) + r] = (bf16)f2bf((acc[i][j] - mean[j]) * rstd[j]);
            bar_sync();
            for (int idx = tid; idx < T * 16; idx += NTHR) { const int l = idx >> 4, ch = idx & 15;
                const v4u yv = *(const LAS v4u*)(Yb + l * SP_A + 8 * ch);
                GAS v4u* gp = (GAS v4u*)(F.PROJ + (size_t)(si.r0 + tb + l) * LP + G0 + 128 * hh + 8 * ch); const v4u gv = *gp;
                v4u o;
#pragma unroll
                for (int k = 0; k < 4; ++k) o[k] = pk2(bflo(yv[k]) * silu(bflo(gv[k])), bfhi(yv[k]) * silu(bfhi(gv[k])));
                *gp = o; }
        }
        const float dch = (MODE == 0) ? 1.f : exp2f(lg2 * (float)T);
#pragma unroll
        for (int i = 0; i < 8; ++i) { sst[i] = sst[i] * dch; sst[i] = mma_tile(Kw + 16 * w * SP_T, SP_T, Vt + 16 * i * SP_T, SP_T, T, sst[i], lane);
            if (MODE != 0) { unsigned long long pk = (unsigned long long)pk2(sst[i][0], sst[i][1]) | ((unsigned long long)pk2(sst[i][2], sst[i][3]) << 32);
                *(LAS unsigned long long*)(St + (16 * i + r) * SP_A + 16 * w + 4 * q) = pk; } }
        bar_sync();
    }
    if (MODE == 0) { bf16* S = (bf16*)F.out + ST_RET + (size_t)(sidx * 8 + hh) * 16384;
#pragma unroll
        for (int i = 0; i < 8; ++i) *(GAS unsigned long long*)(S + (size_t)(16 * i + r) * 128 + 16 * w + 4 * q) = (unsigned long long)pk2(sst[i][0], sst[i][1]) | ((unsigned long long)pk2(sst[i][2], sst[i][3]) << 32); }
    if (MODE == 2) { float* S = F.out + O_RS + (size_t)(sidx * 8 + hh) * 16384;
#pragma unroll
        for (int i = 0; i < 8; ++i)
#pragma unroll
            for (int j = 0; j < 4; ++j) S[(size_t)(16 * w + 4 * q + j) * 128 + 16 * i + r] = sst[i][j]; }
    bar_sync();
}


__device__ __forceinline__ void conv_walk(const Frame& F, int row_first, int nrows, int col, float (&hal)[3][8], float* ncv) {
    float wk[4][8], bs[8];
#pragma unroll
    for (int k = 0; k < 4; ++k) { const f32x4 a = *(const GAS f32x4*)(F.conv_w + k * CONVD + col), b = *(const GAS f32x4*)(F.conv_w + k * CONVD + col + 4);
#pragma unroll
        for (int i = 0; i < 4; ++i) { wk[k][i] = a[i]; wk[k][4 + i] = b[i]; } }
    { const f32x4 a = *(const GAS f32x4*)(F.conv_b + col), b = *(const GAS f32x4*)(F.conv_b + col + 4);
#pragma unroll
      for (int i = 0; i < 4; ++i) { bs[i] = a[i]; bs[4 + i] = b[i]; } }
    GAS bf16* p = (GAS bf16*)(F.PROJ + (size_t)row_first * LP + XBC0 + col);
    v4u rw[8], rn[8];
#pragma unroll
    for (int u = 0; u < 8; ++u) rw[u] = *(const GAS v4u*)(p + (size_t)u * LP);
    for (int t0 = 0; t0 < nrows; t0 += 8) {
        if (t0 + 8 < nrows) {
#pragma unroll
            for (int u = 0; u < 8; ++u) rn[u] = *(const GAS v4u*)(p + (size_t)(t0 + 8 + u) * LP); }
        __builtin_amdgcn_sched_barrier(0);
#pragma unroll
        for (int u = 0; u < 8; ++u) { const int t = t0 + u; float x[8];
#pragma unroll
            for (int i = 0; i < 4; ++i) { x[2 * i] = bflo(rw[u][i]); x[2 * i + 1] = bfhi(rw[u][i]); }
            float y[8];
#pragma unroll
            for (int i = 0; i < 8; ++i) { const float a = bs[i] + hal[0][i] * wk[0][i] + hal[1][i] * wk[1][i] + hal[2][i] * wk[2][i] + x[i] * wk[3][i]; y[i] = silu(a);
                hal[0][i] = hal[1][i]; hal[1][i] = hal[2][i]; hal[2][i] = x[i]; }
            v4u o;
#pragma unroll
            for (int i = 0; i < 4; ++i) o[i] = pk2(y[2 * i], y[2 * i + 1]);
            *(GAS v4u*)(p + (size_t)t * LP) = o;
            if (ncv != nullptr && t >= nrows - 3) { float* q = ncv + (size_t)(t - (nrows - 3)) * CONVD;
#pragma unroll
                for (int i = 0; i < 8; ++i) q[i] = x[i]; } }
#pragma unroll
        for (int u = 0; u < 8; ++u) rw[u] = rn[u];
    }
}
__device__ __forceinline__ int half_col(int g, int cg) { return cg < 64 ? 512 * g + 8 * cg : (cg < 80 ? 1024 + 128 * g + 8 * (cg - 64) : 1280 + 128 * g + 8 * (cg - 80)); }
__device__ __forceinline__ void conv_unit(Frame& F, const int u) {
    const int tid = F.tid, lane = F.lane, w = F.wave;
    {
        const int pm = u >> 1, g = u & 1, r0 = pm * 256;
        if (pm < NPP) {
            const int t2 = tid - 256; const bool lo = tid < 256;
            const int cg = lo ? (tid & 63) : 64 + (t2 & 31), rofs = lo ? 64 * (tid >> 6) : 32 * (t2 >> 5), nrw = lo ? 64 : 32;
            float hal[3][8]; const bool act = true; const int col = half_col(g, cg);
            if (act) {
                const bool seq0 = (pm & 63) == 0 && rofs == 0;
                const GAS bf16* src = (rofs > 0) ? (const GAS bf16*)(F.PROJ + (size_t)(r0 + rofs - 3) * LP + XBC0 + col) : (const GAS bf16*)(F.halo + (size_t)((pm - 1) * 3) * CONVD + col);
                const int pitch = (rofs > 0) ? LP : CONVD;
#pragma unroll
                for (int j = 0; j < 3; ++j) { v4u rw = (v4u){0u, 0u, 0u, 0u}; if (!seq0) rw = *(const GAS v4u*)(src + (size_t)j * pitch);
#pragma unroll
                    for (int i = 0; i < 4; ++i) { hal[j][2 * i] = bflo(rw[i]); hal[j][2 * i + 1] = bfhi(rw[i]); } }
            }
            const int chunk = w & 3, hq = w >> 2;
            float dr[4];
#pragma unroll
            for (int i = 0; i < 4; ++i) dr[i] = bf2f(*(const GAS bf16*)(F.PROJ + (size_t)(r0 + 64 * chunk + lane) * LP + DT0 + 8 * g + 4 * hq + i));
            bar_sync();
            if (act) conv_walk(F, r0 + rofs, nrw, col, hal, nullptr);
#pragma unroll
            for (int i = 0; i < 4; ++i) { const int e = 8 * g + 4 * hq + i; const float dt = softplus_f(dr[i] + F.dt_bias[e]); float sc = dt * -__expf(F.a_log[e]);
#pragma unroll
                for (int o = 1; o < 64; o <<= 1) { const float v = __shfl_up(sc, o); if (lane >= o) sc += v; }
                const size_t ix = (size_t)(r0 + 64 * chunk + lane) * 16 + e; F.misc[MS_DT + ix] = dt; F.misc[MS_ACUM + ix] = sc; }
        } else {
            for (int it = tid; it < 8 * 96; it += NTHR) { const int sq = it / 96, cg = it % 96, col = half_col(g, cg), sb = (pm - NPP) * 8 + sq; float hal[3][8];
#pragma unroll
                for (int j = 0; j < 3; ++j) { const f32x4 a = *(const GAS f32x4*)(F.st_conv + (size_t)(sb * 3 + j) * CONVD + col), b = *(const GAS f32x4*)(F.st_conv + (size_t)(sb * 3 + j) * CONVD + col + 4);
#pragma unroll
                    for (int i = 0; i < 4; ++i) { hal[j][i] = a[i]; hal[j][4 + i] = b[i]; } }
                conv_walk(F, r0 + 32 * sq, 32, col, hal, F.out + O_CS + (size_t)(sb * 3) * CONVD + col); }
            const int chunk = w & 3, hq = w >> 2;
#pragma unroll
            for (int i = 0; i < 4; ++i) { const int e = 8 * g + 4 * hq + i; const size_t row = (size_t)(r0 + 64 * chunk + lane);
                const float dt = softplus_f(bf2f(*(const GAS bf16*)(F.PROJ + row * LP + DT0 + e)) + F.dt_bias[e]); float sc = dt * -__expf(F.a_log[e]);
#pragma unroll
                for (int o = 1; o < 32; o <<= 1) { const float v = __shfl_up(sc, o); if ((lane & 31) >= o) sc += v; }
                F.misc[MS_DT + row * 16 + e] = dt; F.misc[MS_ACUM + row * 16 + e] = sc; }
        }
        bar_sync();
    }
}

typedef short v4i16_t __attribute__((ext_vector_type(4)));
typedef unsigned u32x4v __attribute__((ext_vector_type(4)));
constexpr int PK = 272, PX = 144;
__device__ __forceinline__ v4i16_t lds_tr(const LAS unsigned char* p) { return __builtin_amdgcn_ds_read_tr16_b64_v4i16((LAS v4i16_t*)p); }
__device__ __forceinline__ bf16x8 frag_row(const LAS unsigned char* img, int pitch, int i0, int k0, int lane) { return *(const LAS bf16x8*)(img + (i0 + (lane & 15)) * pitch + (k0 + 8 * (lane >> 4)) * 2); }
__device__ __forceinline__ bf16x8 frag_tr(const LAS unsigned char* img, int pitch, int k0, int i0, int lane) {
    const int g = lane >> 4, q = (lane & 15) >> 2, pp = lane & 3; const LAS unsigned char* a = img + (k0 + 8 * g + q) * pitch + i0 * 2 + 8 * pp;
    const v4i16_t lo = lds_tr(a), hi = lds_tr(a + 4 * pitch); return __builtin_shufflevector(lo, hi, 0, 1, 2, 3, 4, 5, 6, 7);
}
__device__ __forceinline__ bf16x8 frag_tr_perm(const LAS unsigned char* img, int pitch, int k0, int i0, int lane) {
    const int g = lane >> 4, q = (lane & 15) >> 2, pp = lane & 3; const LAS unsigned char* a = img + (k0 + 4 * g + q) * pitch + i0 * 2 + 8 * pp;
    const v4i16_t lo = lds_tr(a), hi = lds_tr(a + 16 * pitch); return __builtin_shufflevector(lo, hi, 0, 1, 2, 3, 4, 5, 6, 7);
}
#define MFMA16(a, b, c) __builtin_amdgcn_mfma_f32_16x16x32_bf16((a), (b), (c), 0, 0, 0)
__device__ __forceinline__ void stage128(LAS unsigned char* img, const bf16* src, int tid) {
#pragma unroll
    for (int i = 0; i < 8; ++i) { const int id = tid + NTHR * i, row = id >> 4, ch = id & 15; *(LAS v4u*)(img + row * PK + 16 * ch) = *(const GAS v4u*)(src + (size_t)row * LP + 8 * ch); }
}
__device__ __forceinline__ void stage128_swz(LAS unsigned char* img, const bf16* src, int tid) {
#pragma unroll
    for (int i = 0; i < 8; ++i) { const int id = tid + NTHR * i, row = id >> 4, ch = id & 15; *(LAS v4u*)(img + row * 256 + 16 * (ch ^ (row & 7))) = *(const GAS v4u*)(src + (size_t)row * LP + 8 * ch); }
}
__device__ __forceinline__ bf16x8 frag_row_swz(const LAS unsigned char* img, int i0, int k0, int lane) { const int row = i0 + (lane & 15), ch = (k0 >> 3) + (lane >> 4); return *(const LAS bf16x8*)(img + row * 256 + 16 * (ch ^ (row & 7))); }
constexpr int NA_B = 0, NA_X = 256 * PK, NA_END = NA_X + 2 * 256 * PX;
static_assert(NA_END <= SCAN_LDS, "ssd local-state LDS map");
__device__ __forceinline__ void ssd_local_unit(Frame& F, const int gp, const int g) {
    LAS unsigned char* L = F.lds;
    int tid = F.tid; asm volatile("" : "+v"(tid)); const int lane = tid & 63, w = F.wave, r0 = gp * 256;
    stage128(L + NA_B, F.PROJ + (size_t)r0 * LP + XB0 + 128 * g, tid); __builtin_amdgcn_sched_barrier(0);
    const int srow = tid >> 3, sch = tid & 7;
    auto load_head = [&](int e, v4u (&xr)[4], float (&ww)[4], float (&tot)[4], float (&dtv)[4]) { const float* AC = F.misc + MS_ACUM + (size_t)r0 * 16 + e; const float* DT = F.misc + MS_DT + (size_t)r0 * 16 + e;
#pragma unroll
        for (int i = 0; i < 4; ++i) tot[i] = AC[(size_t)(64 * i + 63) * 16];
#pragma unroll
        for (int i = 0; i < 4; ++i) { const int row = srow + 64 * i; xr[i] = *(const GAS v4u*)(F.PROJ + (size_t)(r0 + row) * LP + XBC0 + 64 * e + 8 * sch);
            ww[i] = AC[(size_t)row * 16]; dtv[i] = DT[(size_t)row * 16]; } };
    auto park_head = [&](int buf, int e, const v4u (&xr)[4], const float (&ac)[4], const float (&tot)[4], const float (&dtv)[4]) {
        const float atot = (tot[0] + tot[1]) + (tot[2] + tot[3]); float off = 0.f;
        if (tid == 0) F.misc[MS_DEC + (size_t)gp * 16 + e] = __expf(atot);
#pragma unroll
        for (int i = 0; i < 4; ++i) { const float wi = __expf(atot - (ac[i] + off)) * dtv[i]; off += tot[i]; v4u o;
#pragma unroll
            for (int k = 0; k < 4; ++k) o[k] = pkh(bflo(xr[i][k]) * wi, bfhi(xr[i][k]) * wi);
            *(LAS v4u*)(L + NA_X + buf * 256 * PX + (srow + 64 * i) * PX + 16 * sch) = o; } };
    { v4u xr[4]; float ww[4], tot[4], dtv[4]; load_head(8 * g, xr, ww, tot, dtv); park_head(0, 8 * g, xr, ww, tot, dtv); }
    bar_sync();
    for (int e8 = 0; e8 < 8; ++e8) { const int e = 8 * g + e8, buf = e8 & 1; const LAS unsigned char* XI = L + NA_X + buf * 256 * PX;
        v4u xr[4]; float ww[4], tot[4], dtv[4];
        if (e8 < 7) load_head(e + 1, xr, ww, tot, dtv);
        f32x4 acc[4];
#pragma unroll
        for (int pt = 0; pt < 4; ++pt) acc[pt] = (f32x4){0.f, 0.f, 0.f, 0.f};
#pragma unroll
        for (int ks = 0; ks < 8; ks += 2) { bf16x8 a[2], b[2][4];
#pragma unroll
            for (int k2 = 0; k2 < 2; ++k2) { a[k2] = frag_tr(L + NA_B, PK, 32 * (ks + k2), 16 * w, lane);
#pragma unroll
                for (int pt = 0; pt < 4; ++pt) b[k2][pt] = frag_tr(XI, PX, 32 * (ks + k2), 16 * pt, lane); }
            __builtin_amdgcn_sched_barrier(0);
#pragma unroll
            for (int k2 = 0; k2 < 2; ++k2)
#pragma unroll
                for (int pt = 0; pt < 4; ++pt) acc[pt] = MFMA16(a[k2], b[k2][pt], acc[pt]);
            __builtin_amdgcn_sched_barrier(0); }
        bf16* S = (bf16*)F.out + ST_SSD + (size_t)(gp * 16 + e) * 8192;
#pragma unroll
        for (int pt = 0; pt < 4; ++pt) *(GAS unsigned long long*)(S + (size_t)(16 * pt + (lane & 15)) * 128 + 16 * w + 4 * (lane >> 4)) = (unsigned long long)pkh(acc[pt][0], acc[pt][1]) | ((unsigned long long)pkh(acc[pt][2], acc[pt][3]) << 32);
        if (e8 < 7) park_head(buf ^ 1, e + 1, xr, ww, tot, dtv);
        lds_barrier();
    }
    bar_sync();
}
constexpr int NC_K = 0, NC_V = 256 * PK;
static_assert(NC_V + 256 * PK <= SCAN_LDS, "retention LDS map");
__device__ __forceinline__ void ret_local_units(Frame& F) {
    LAS unsigned char* L = F.lds; int tid = F.tid; asm volatile("" : "+v"(tid)); const int lane = tid & 63, w = F.wave;
    constexpr int NU_RET_P = NPP * RH; int u = F.vcu; if (u >= NU_RET_P) return;
    { const int gp = u >> 3, hh = u & 7; stage128(L + NC_K, F.PROJ + (size_t)gp * 256 * LP + K0 + 128 * hh, tid); stage128(L + NC_V, F.PROJ + (size_t)gp * 256 * LP + V0 + 128 * hh, tid); }
    bar_sync();
    for (;;) { const int gp = u >> 3, hh = u & 7, un = u + F.G; const bool more = un < NU_RET_P;
        v4u kr[8], vr[8];
        if (more) { const bf16* kp = F.PROJ + (size_t)(un >> 3) * 256 * LP + K0 + 128 * (un & 7); const bf16* vp = F.PROJ + (size_t)(un >> 3) * 256 * LP + V0 + 128 * (un & 7);
#pragma unroll
            for (int i = 0; i < 8; ++i) { const int id = tid + NTHR * i, row = id >> 4, ch = id & 15; kr[i] = *(const GAS v4u*)(kp + (size_t)row * LP + 8 * ch); vr[i] = *(const GAS v4u*)(vp + (size_t)row * LP + 8 * ch); } }
        f32x4 acc[8];
#pragma unroll
        for (int et = 0; et < 8; ++et) acc[et] = (f32x4){0.f, 0.f, 0.f, 0.f};
#pragma unroll 2
        for (int ks = 0; ks < 8; ++ks) { const bf16x8 a = frag_tr(L + NC_K, PK, 32 * ks, 16 * w, lane); bf16x8 b[8];
#pragma unroll
            for (int et = 0; et < 8; ++et) b[et] = frag_tr(L + NC_V, PK, 32 * ks, 16 * et, lane);
            __builtin_amdgcn_sched_barrier(0);
#pragma unroll
            for (int et = 0; et < 8; ++et) acc[et] = MFMA16(a, b[et], acc[et]);
            __builtin_amdgcn_sched_barrier(0); }
        const float sc = exp2f(255.0f * log2f(1.0f - exp2f(-5.0f - (float)hh)));
        bf16* S = (bf16*)F.out + ST_RET + (size_t)(gp * 8 + hh) * 16384;
#pragma unroll
        for (int et = 0; et < 8; ++et) *(GAS unsigned long long*)(S + (size_t)(16 * et + (lane & 15)) * 128 + 16 * w + 4 * (lane >> 4)) =
            (unsigned long long)pkh(acc[et][0] * sc, acc[et][1] * sc) | ((unsigned long long)pkh(acc[et][2] * sc, acc[et][3] * sc) << 32);
        if (!more) break;
        lds_barrier();
#pragma unroll
        for (int i = 0; i < 8; ++i) { const int id = tid + NTHR * i, row = id >> 4, ch = id & 15; *(LAS v4u*)(L + NC_K + row * PK + 16 * ch) = kr[i]; *(LAS v4u*)(L + NC_V + row * PK + 16 * ch) = vr[i]; }
        lds_barrier();
        u = un;
    }
    bar_sync();
}
__device__ __forceinline__ void ret_out_unit(Frame& F, const int gp, const int hh) {
    LAS unsigned char* L = F.lds; int tid = F.tid; asm volatile("" : "+v"(tid));
    const int lane = tid & 63, w = F.wave, r0 = gp * 256, g = lane >> 4, r = lane & 15;
    bf16x8 qf[2][4];
#pragma unroll
    for (int lt = 0; lt < 2; ++lt)
#pragma unroll
        for (int ks = 0; ks < 4; ++ks) qf[lt][ks] = *(const GAS bf16x8*)(F.PROJ + (size_t)(r0 + 32 * w + 16 * lt + r) * LP + Q0 + 128 * hh + 32 * ks + 8 * g);
    { v4u kr[8], vr[8]; const bf16* kp = F.PROJ + (size_t)r0 * LP + K0 + 128 * hh; const bf16* vp = F.PROJ + (size_t)r0 * LP + V0 + 128 * hh;
#pragma unroll
      for (int i = 0; i < 8; ++i) { const int id = tid + NTHR * i, row = id >> 4, ch = id & 15; kr[i] = *(const GAS v4u*)(kp + (size_t)row * LP + 8 * ch); vr[i] = *(const GAS v4u*)(vp + (size_t)row * LP + 8 * ch); }
      __builtin_amdgcn_sched_barrier(0);
#pragma unroll
      for (int i = 0; i < 8; ++i) { const int id = tid + NTHR * i, row = id >> 4, ch = id & 15; *(LAS v4u*)(L + NC_K + row * PK + 16 * ch) = kr[i]; *(LAS v4u*)(L + NC_V + row * PK + 16 * ch) = vr[i]; }
      __builtin_amdgcn_sched_barrier(0); }
    const float gam = 1.0f - exp2f(-5.0f - (float)hh);
    f32x4 acc[8][2];
    { const bf16* S = (const bf16*)F.out + ST_RET + (size_t)(gp * 8 + hh) * 16384;
#pragma unroll
      for (int eh = 0; eh < 2; ++eh) { bf16x8 a[4][4];
#pragma unroll
          for (int e4 = 0; e4 < 4; ++e4)
#pragma unroll
              for (int ks = 0; ks < 4; ++ks) a[e4][ks] = *(const GAS bf16x8*)(S + (size_t)(16 * (4 * eh + e4) + r) * 128 + 32 * ks + 8 * g);
          __builtin_amdgcn_sched_barrier(0);
#pragma unroll
          for (int e4 = 0; e4 < 4; ++e4) { const int et = 4 * eh + e4; acc[et][0] = (f32x4){0.f, 0.f, 0.f, 0.f}; acc[et][1] = (f32x4){0.f, 0.f, 0.f, 0.f};
#pragma unroll
              for (int ks = 0; ks < 4; ++ks) { acc[et][0] = MFMA16(a[e4][ks], qf[0][ks], acc[et][0]); acc[et][1] = MFMA16(a[e4][ks], qf[1][ks], acc[et][1]); }
              acc[et][0] = acc[et][0] * gam; acc[et][1] = acc[et][1] * gam; }
          __builtin_amdgcn_sched_barrier(0); } }
    bar_sync();
    unsigned long long gpre[2][8];
#pragma unroll
    for (int lt = 0; lt < 2; ++lt)
#pragma unroll
        for (int et = 0; et < 8; ++et) gpre[lt][et] = *(const GAS unsigned long long*)(F.PROJ + (size_t)(r0 + 32 * w + 16 * lt + r) * LP + G0 + 128 * hh + 4 * g + 16 * et);
    for (int sb = 0; sb <= w; ++sb) {
        f32x4 pt[2][2];
#pragma unroll
        for (int st = 0; st < 2; ++st) { pt[st][0] = (f32x4){0.f, 0.f, 0.f, 0.f}; pt[st][1] = (f32x4){0.f, 0.f, 0.f, 0.f}; }
        bf16x8 af[4][2];
#pragma unroll
        for (int ks = 0; ks < 4; ++ks)
#pragma unroll
            for (int st = 0; st < 2; ++st) af[ks][st] = frag_row(L + NC_K, PK, 32 * sb + 16 * st, 32 * ks, lane);
        __builtin_amdgcn_sched_barrier(0);
#pragma unroll
        for (int ks = 0; ks < 4; ++ks)
#pragma unroll
            for (int st = 0; st < 2; ++st) { pt[st][0] = MFMA16(af[ks][st], qf[0][ks], pt[st][0]); pt[st][1] = MFMA16(af[ks][st], qf[1][ks], pt[st][1]); }
        __builtin_amdgcn_sched_barrier(0);
        bf16x8 vf[8];
#pragma unroll
        for (int et = 0; et < 8; ++et) vf[et] = frag_tr_perm(L + NC_V, PK, 32 * sb, 16 * et, lane);
        __builtin_amdgcn_sched_barrier(0);
        if (sb == w) {
#pragma unroll
            for (int st = 0; st < 2; ++st)
#pragma unroll
                for (int lt = 0; lt < 2; ++lt)
#pragma unroll
                    for (int j = 0; j < 4; ++j) if (16 * st + 4 * g + j > 16 * lt + r) pt[st][lt][j] = 0.f;
        }
        bf16x8 pf[2];
#pragma unroll
        for (int lt = 0; lt < 2; ++lt) { u32x4v pw; pw[0] = pkh(pt[0][lt][0], pt[0][lt][1]); pw[1] = pkh(pt[0][lt][2], pt[0][lt][3]); pw[2] = pkh(pt[1][lt][0], pt[1][lt][1]); pw[3] = pkh(pt[1][lt][2], pt[1][lt][3]);
            pf[lt] = __builtin_bit_cast(bf16x8, pw); }
#pragma unroll
        for (int et = 0; et < 8; ++et) { acc[et][0] = MFMA16(vf[et], pf[0], acc[et][0]); acc[et][1] = MFMA16(vf[et], pf[1], acc[et][1]); }
    }
#pragma unroll
    for (int lt = 0; lt < 2; ++lt) {
        float sm = 0.f;
#pragma unroll
        for (int et = 0; et < 8; ++et) sm += (acc[et][lt][0] + acc[et][lt][1]) + (acc[et][lt][2] + acc[et][lt][3]);
        sm += __shfl_xor(sm, 16); sm += __shfl_xor(sm, 32);
        const float mean = sm * (1.0f / 128.0f); float d2 = 0.f;
#pragma unroll
        for (int et = 0; et < 8; ++et)
#pragma unroll
            for (int j = 0; j < 4; ++j) { const float d = acc[et][lt][j] - mean; d2 += d * d; }
        d2 += __shfl_xor(d2, 16); d2 += __shfl_xor(d2, 32);
        const float rstd = 1.0f / sqrtf(d2 * (1.0f / 128.0f) + EPS);
        bf16* grow = F.PROJ + (size_t)(r0 + 32 * w + 16 * lt + r) * LP + G0 + 128 * hh + 4 * g;
#pragma unroll
        for (int et = 0; et < 8; ++et) { GAS unsigned long long* gp8 = (GAS unsigned long long*)(grow + 16 * et); const unsigned long long gv = gpre[lt][et]; const unsigned g0 = (unsigned)gv, g1 = (unsigned)(gv >> 32);
            const float y0 = (acc[et][lt][0] - mean) * rstd * silu(bflo(g0)), y1 = (acc[et][lt][1] - mean) * rstd * silu(bfhi(g0)), y2 = (acc[et][lt][2] - mean) * rstd * silu(bflo(g1)), y3 = (acc[et][lt][3] - mean) * rstd * silu(bfhi(g1));
            *gp8 = (unsigned long long)pkh(y0, y1) | ((unsigned long long)pkh(y2, y3) << 32); }
    }
    bar_sync();
}

constexpr int ND_B = 0, ND_X = 256 * PK, ND_A = ND_X + 256 * PX, ND_D = ND_A + 256 * 4, ND_END = ND_D + 256 * 4;
static_assert(ND_END <= SCAN_LDS, "ssd output LDS map");
__device__ __forceinline__ void ssd_out_unit(Frame& F, const int gp, const int e) {
    LAS unsigned char* L = F.lds; LAS float* acP = (LAS float*)(L + ND_A); LAS float* dtv = (LAS float*)(L + ND_D);
    const int tid = F.tid, lane = F.lane, w = F.wave, r0 = gp * 256, g = e >> 3, gq = lane >> 4, r = lane & 15;
    stage128(L + ND_B, F.PROJ + (size_t)r0 * LP + XB0 + 128 * g, tid); __builtin_amdgcn_sched_barrier(0);
#pragma unroll
    for (int i = 0; i < 4; ++i) { const int id = tid + NTHR * i, row = id >> 3, ch = id & 7; *(LAS v4u*)(L + ND_X + row * PX + 16 * ch) = *(const GAS v4u*)(F.PROJ + (size_t)(r0 + row) * LP + XBC0 + 64 * e + 8 * ch); }
    if (tid < 256) { const float* AC = F.misc + MS_ACUM + (size_t)r0 * 16 + e; float off = 0.f;
#pragma unroll
        for (int i = 0; i < 3; ++i) { const float x = AC[(size_t)(64 * i + 63) * 16]; if (i < (tid >> 6)) off += x; }
        acP[tid] = AC[(size_t)tid * 16] + off; dtv[tid] = F.misc[MS_DT + (size_t)(r0 + tid) * 16 + e]; }
    __builtin_amdgcn_sched_barrier(0);
    bf16x8 cf[2][4];
#pragma unroll
    for (int lt = 0; lt < 2; ++lt)
#pragma unroll
        for (int ks = 0; ks < 4; ++ks) cf[lt][ks] = *(const GAS bf16x8*)(F.PROJ + (size_t)(r0 + 32 * w + 16 * lt + r) * LP + XC0 + 128 * g + 32 * ks + 8 * gq);
    f32x4 acc[4][2];
    { const bf16* S = (const bf16*)F.out + ST_SSD + (size_t)(gp * 16 + e) * 8192;
#pragma unroll
      for (int pt = 0; pt < 4; ++pt) { acc[pt][0] = (f32x4){0.f, 0.f, 0.f, 0.f}; acc[pt][1] = (f32x4){0.f, 0.f, 0.f, 0.f};
#pragma unroll
          for (int ks = 0; ks < 4; ++ks) { const bf16x8 a = *(const GAS bf16x8*)(S + (size_t)(16 * pt + r) * 128 + 32 * ks + 8 * gq);
              acc[pt][0] = MFMA16(a, cf[0][ks], acc[pt][0]); acc[pt][1] = MFMA16(a, cf[1][ks], acc[pt][1]); }
          __builtin_amdgcn_sched_barrier(0); } }
    bar_sync();
    float al[2];
#pragma unroll
    for (int lt = 0; lt < 2; ++lt) { al[lt] = acP[32 * w + 16 * lt + r]; const float ex = __expf(al[lt]);
#pragma unroll
        for (int pt = 0; pt < 4; ++pt) acc[pt][lt] = acc[pt][lt] * ex; }
    const float dsk = F.d_skip[e];
    for (int sb = 0; sb <= w; ++sb) {
        f32x4 pt2[2][2];
#pragma unroll
        for (int st = 0; st < 2; ++st) { pt2[st][0] = (f32x4){0.f, 0.f, 0.f, 0.f}; pt2[st][1] = (f32x4){0.f, 0.f, 0.f, 0.f}; }
#pragma unroll
        for (int ks = 0; ks < 4; ++ks)
#pragma unroll
            for (int st = 0; st < 2; ++st) { const bf16x8 a = frag_row(L + ND_B, PK, 32 * sb + 16 * st, 32 * ks, lane);
                pt2[st][0] = MFMA16(a, cf[0][ks], pt2[st][0]); pt2[st][1] = MFMA16(a, cf[1][ks], pt2[st][1]); }
        const bool diag = (sb == w);
#pragma unroll
        for (int st = 0; st < 2; ++st) { const f32x4 as = *(const LAS f32x4*)(acP + 32 * sb + 16 * st + 4 * gq), ds = *(const LAS f32x4*)(dtv + 32 * sb + 16 * st + 4 * gq);
#pragma unroll
            for (int lt = 0; lt < 2; ++lt)
#pragma unroll
                for (int j = 0; j < 4; ++j) { float m = pt2[st][lt][j] * __expf(al[lt] - as[j]) * ds[j];
                    if (diag) { const int sr = 16 * st + 4 * gq + j, lr = 16 * lt + r; if (sr > lr) m = 0.f; if (sr == lr) m += dsk; }
                    pt2[st][lt][j] = m; } }
        bf16x8 pf[2];
#pragma unroll
        for (int lt = 0; lt < 2; ++lt) { u32x4v pw; pw[0] = pk2(pt2[0][lt][0], pt2[0][lt][1]); pw[1] = pk2(pt2[0][lt][2], pt2[0][lt][3]); pw[2] = pk2(pt2[1][lt][0], pt2[1][lt][1]); pw[3] = pk2(pt2[1][lt][2], pt2[1][lt][3]);
            pf[lt] = __builtin_bit_cast(bf16x8, pw); }
#pragma unroll
        for (int pt = 0; pt < 4; ++pt) { const bf16x8 a = frag_tr_perm(L + ND_X, PX, 32 * sb, 16 * pt, lane);
            acc[pt][0] = MFMA16(a, pf[0], acc[pt][0]); acc[pt][1] = MFMA16(a, pf[1], acc[pt][1]); }
    }
#pragma unroll
    for (int lt = 0; lt < 2; ++lt) { const size_t row = (size_t)(r0 + 32 * w + 16 * lt + r); bf16* zrow = F.PROJ + row * LP + Z0 + 64 * e + 4 * gq; float ss = 0.f;
#pragma unroll
        for (int pt = 0; pt < 4; ++pt) { GAS unsigned long long* zp = (GAS unsigned long long*)(zrow + 16 * pt); const unsigned long long zv = *zp; const unsigned z0 = (unsigned)zv, z1 = (unsigned)(zv >> 32);
            const float y0 = acc[pt][lt][0] * silu(bflo(z0)), y1 = acc[pt][lt][1] * silu(bfhi(z0)), y2 = acc[pt][lt][2] * silu(bflo(z1)), y3 = acc[pt][lt][3] * silu(bfhi(z1));
            ss += (y0 * y0 + y1 * y1) + (y2 * y2 + y3 * y3);
            *zp = (unsigned long long)pk2(y0, y1) | ((unsigned long long)pk2(y2, y3) << 32); }
        ss += __shfl_xor(ss, 16); ss += __shfl_xor(ss, 32);
        if (gq == 0) F.misc[MS_SSQ + row * 16 + e] = ss; }
    bar_sync();
}

constexpr int NG_B = 0, NG_X = 256 * 256, NG_V = NG_X + 2 * 256 * PX, NG_H = NG_V + 2 * 2048, NG_U = NG_H + 64 * PK, NG_END = NG_U + 2 * 1024;
static_assert(NG_END <= SCAN_LDS, "ssd group output LDS map");
__device__ __forceinline__ void ssd_out_group_unit(Frame& F, const int gp, const int g) {
    LAS unsigned char* L = F.lds;
    int tid = F.tid; asm volatile("" : "+v"(tid));
    const int lane = tid & 63, w = (F.wave < 4) ? 7 - F.wave : F.wave - 4, r0 = gp * 256, gq = lane >> 4, r = lane & 15;
    stage128_swz(L + NG_B, F.PROJ + (size_t)r0 * LP + XB0 + 128 * g, tid); __builtin_amdgcn_sched_barrier(0);
    auto vec_load = [&](int e, float& ap, float& dt) { ap = 0.f; dt = 0.f; if (tid < 256) { const float* AC = F.misc + MS_ACUM + (size_t)r0 * 16 + e; float off = 0.f;
#pragma unroll
            for (int i = 0; i < 3; ++i) { const float x = AC[(size_t)(64 * i + 63) * 16]; if (i < (tid >> 6)) off += x; }
            ap = AC[(size_t)tid * 16] + off; dt = F.misc[MS_DT + (size_t)(r0 + tid) * 16 + e]; } };
    { v4u xr[4]; float ap, dt;
#pragma unroll
      for (int i = 0; i < 4; ++i) { const int id = tid + NTHR * i, row = id >> 3, ch = id & 7; xr[i] = *(const GAS v4u*)(F.PROJ + (size_t)(r0 + row) * LP + XBC0 + 64 * (8 * g) + 8 * ch); }
      vec_load(8 * g, ap, dt);
#pragma unroll
      for (int i = 0; i < 4; ++i) { const int id = tid + NTHR * i, row = id >> 3, ch = id & 7; *(LAS v4u*)(L + NG_X + row * PX + 16 * ch) = xr[i]; }
      if (tid < 256) { ((LAS float*)(L + NG_V))[tid] = ap; ((LAS float*)(L + NG_V))[256 + tid] = dt; ((LAS float*)(L + NG_U))[tid] = __expf(__shfl(ap, (lane & 32) | 31) - ap) * dt; }
      const bf16* S = (const bf16*)F.out + ST_SSD + (size_t)(gp * 16 + 8 * g) * 8192;
#pragma unroll
      for (int i = 0; i < 2; ++i) { const int id = tid + NTHR * i, row = id >> 4, ch = id & 15; *(LAS v4u*)(L + NG_H + row * PK + 16 * ch) = *(const GAS v4u*)(S + (size_t)row * 128 + 8 * ch); } }
    bf16x8 cf[2][4];
#pragma unroll
    for (int lt = 0; lt < 2; ++lt)
#pragma unroll
        for (int ks = 0; ks < 4; ++ks) cf[lt][ks] = *(const GAS bf16x8*)(F.PROJ + (size_t)(r0 + 32 * w + 16 * lt + r) * LP + XC0 + 128 * g + 32 * ks + 8 * gq);
    float ssq[2] = {0.f, 0.f};
    bar_sync();
    for (int e8 = 0; e8 < 8; ++e8) { const int e = 8 * g + e8, buf = e8 & 1;
        const LAS unsigned char* XI = L + NG_X + buf * 256 * PX; const LAS float* acP = (const LAS float*)(L + NG_V + buf * 2048); const LAS float* dtv = acP + 256; const LAS float* usP = (const LAS float*)(L + NG_U + buf * 1024);
        unsigned long long zpre[2][4];
#pragma unroll
        for (int lt = 0; lt < 2; ++lt)
#pragma unroll
            for (int pt = 0; pt < 4; ++pt) zpre[lt][pt] = *(const GAS unsigned long long*)(F.PROJ + (size_t)(r0 + 32 * w + 16 * lt + r) * LP + Z0 + 64 * e + 4 * gq + 16 * pt);
        f32x4 acc[4][2];
#pragma unroll
        for (int ph = 0; ph < 2; ++ph) { bf16x8 hf[2][4];
#pragma unroll
          for (int p2 = 0; p2 < 2; ++p2)
#pragma unroll
              for (int ks = 0; ks < 4; ++ks) hf[p2][ks] = frag_row(L + NG_H, PK, 16 * (2 * ph + p2), 32 * ks, lane);
          __builtin_amdgcn_sched_barrier(0);
#pragma unroll
          for (int p2 = 0; p2 < 2; ++p2) { const int pt = 2 * ph + p2; acc[pt][0] = (f32x4){0.f, 0.f, 0.f, 0.f}; acc[pt][1] = (f32x4){0.f, 0.f, 0.f, 0.f};
#pragma unroll
              for (int ks = 0; ks < 4; ++ks) { acc[pt][0] = MFMA16(hf[p2][ks], cf[0][ks], acc[pt][0]); acc[pt][1] = MFMA16(hf[p2][ks], cf[1][ks], acc[pt][1]); } }
          __builtin_amdgcn_sched_barrier(0); }
        lds_barrier();
        v4u xr[4]; float apn = 0.f, dtn = 0.f;
        if (e8 < 7) {
#pragma unroll
            for (int i = 0; i < 4; ++i) { const int id = tid + NTHR * i, row = id >> 3, ch = id & 7; xr[i] = *(const GAS v4u*)(F.PROJ + (size_t)(r0 + row) * LP + XBC0 + 64 * (e + 1) + 8 * ch); }
            vec_load(e + 1, apn, dtn); }
        v4u hr[2];
        if (e8 < 7) { const bf16* S = (const bf16*)F.out + ST_SSD + (size_t)(gp * 16 + e + 1) * 8192;
#pragma unroll
            for (int i = 0; i < 2; ++i) { const int id = tid + NTHR * i, row = id >> 4, ch = id & 15; hr[i] = *(const GAS v4u*)(S + (size_t)row * 128 + 8 * ch); } }
        float al[2];
#pragma unroll
        for (int lt = 0; lt < 2; ++lt) { al[lt] = acP[32 * w + 16 * lt + r]; const float ex = __expf(al[lt]);
#pragma unroll
            for (int pt = 0; pt < 4; ++pt) acc[pt][lt] = acc[pt][lt] * ex; }
        const float dsk = F.d_skip[e];
        for (int sb = 0; sb <= w; ++sb) {
            f32x4 pt2[2][2];
#pragma unroll
            for (int st = 0; st < 2; ++st) { pt2[st][0] = (f32x4){0.f, 0.f, 0.f, 0.f}; pt2[st][1] = (f32x4){0.f, 0.f, 0.f, 0.f}; }
            bf16x8 af[4][2];
#pragma unroll
            for (int ks = 0; ks < 4; ++ks)
#pragma unroll
                for (int st = 0; st < 2; ++st) af[ks][st] = frag_row_swz(L + NG_B, 32 * sb + 16 * st, 32 * ks, lane);
            bf16x8 xf[4];
#pragma unroll
            for (int pt = 0; pt < 4; ++pt) xf[pt] = frag_tr_perm(XI, PX, 32 * sb, 16 * pt, lane);
            const f32x4 us0 = *(const LAS f32x4*)(usP + 32 * sb + 4 * gq), us1 = *(const LAS f32x4*)(usP + 32 * sb + 16 + 4 * gq);
            __builtin_amdgcn_sched_barrier(0);
#pragma unroll
            for (int ks = 0; ks < 4; ++ks)
#pragma unroll
                for (int st = 0; st < 2; ++st) { pt2[st][0] = MFMA16(af[ks][st], cf[0][ks], pt2[st][0]); pt2[st][1] = MFMA16(af[ks][st], cf[1][ks], pt2[st][1]); }
            if (sb == w) {
                const f32x4 as0 = *(const LAS f32x4*)(acP + 32 * sb + 4 * gq), as1 = *(const LAS f32x4*)(acP + 32 * sb + 16 + 4 * gq), ds0 = *(const LAS f32x4*)(dtv + 32 * sb + 4 * gq), ds1 = *(const LAS f32x4*)(dtv + 32 * sb + 16 + 4 * gq);
#pragma unroll
                for (int st = 0; st < 2; ++st) { const f32x4 as = st ? as1 : as0, ds = st ? ds1 : ds0;
#pragma unroll
                    for (int lt = 0; lt < 2; ++lt)
#pragma unroll
                        for (int j = 0; j < 4; ++j) { float m = pt2[st][lt][j] * __expf(al[lt] - as[j]) * ds[j];
                            const int sr = 16 * st + 4 * gq + j, lr = 16 * lt + r; if (sr > lr) m = 0.f; if (sr == lr) m += dsk;
                            pt2[st][lt][j] = m; } }
            } else {
                const float ref = acP[32 * sb + 31]; const float v0 = __expf(al[0] - ref), v1 = __expf(al[1] - ref);
#pragma unroll
                for (int st = 0; st < 2; ++st) { const f32x4 us = st ? us1 : us0;
#pragma unroll
                    for (int j = 0; j < 4; ++j) { pt2[st][0][j] = pt2[st][0][j] * (us[j] * v0); pt2[st][1][j] = pt2[st][1][j] * (us[j] * v1); } }
            }
            bf16x8 pf[2];
#pragma unroll
            for (int lt = 0; lt < 2; ++lt) { u32x4v pw; pw[0] = pkh(pt2[0][lt][0], pt2[0][lt][1]); pw[1] = pkh(pt2[0][lt][2], pt2[0][lt][3]); pw[2] = pkh(pt2[1][lt][0], pt2[1][lt][1]); pw[3] = pkh(pt2[1][lt][2], pt2[1][lt][3]);
                pf[lt] = __builtin_bit_cast(bf16x8, pw); }
#pragma unroll
            for (int pt = 0; pt < 4; ++pt) { acc[pt][0] = MFMA16(xf[pt], pf[0], acc[pt][0]); acc[pt][1] = MFMA16(xf[pt], pf[1], acc[pt][1]); }
        }
#pragma unroll
        for (int lt = 0; lt < 2; ++lt) { const size_t row = (size_t)(r0 + 32 * w + 16 * lt + r); bf16* zrow = F.PROJ + row * LP + Z0 + 64 * e + 4 * gq; float ss = 0.f;
#pragma unroll
            for (int pt = 0; pt < 4; ++pt) { GAS unsigned long long* zp = (GAS unsigned long long*)(zrow + 16 * pt); const unsigned long long zv = zpre[lt][pt]; const unsigned z0 = (unsigned)zv, z1 = (unsigned)(zv >> 32);
                const float y0 = acc[pt][lt][0] * silu(bflo(z0)), y1 = acc[pt][lt][1] * silu(bfhi(z0)), y2 = acc[pt][lt][2] * silu(bflo(z1)), y3 = acc[pt][lt][3] * silu(bfhi(z1));
                ss += (y0 * y0 + y1 * y1) + (y2 * y2 + y3 * y3);
                *zp = (unsigned long long)pkh(y0, y1) | ((unsigned long long)pkh(y2, y3) << 32); }
            ss += __shfl_xor(ss, 16); ss += __shfl_xor(ss, 32); ssq[lt] += ss; }
        if (e8 < 7) { LAS unsigned char* XO = L + NG_X + (buf ^ 1) * 256 * PX; LAS float* vo = (LAS float*)(L + NG_V + (buf ^ 1) * 2048);
#pragma unroll
            for (int i = 0; i < 4; ++i) { const int id = tid + NTHR * i, row = id >> 3, ch = id & 7; *(LAS v4u*)(XO + row * PX + 16 * ch) = xr[i]; }
            if (tid < 256) { vo[tid] = apn; vo[256 + tid] = dtn; ((LAS float*)(L + NG_U + (buf ^ 1) * 1024))[tid] = __expf(__shfl(apn, (lane & 32) | 31) - apn) * dtn; }
#pragma unroll
            for (int i = 0; i < 2; ++i) { const int id = tid + NTHR * i, row = id >> 4, ch = id & 15; *(LAS v4u*)(L + NG_H + row * PK + 16 * ch) = hr[i]; } }
        lds_barrier();
    }
#pragma unroll
    for (int lt = 0; lt < 2; ++lt) { const float rs = 1.0f / sqrtf(ssq[lt] * (1.0f / 512.0f) + EPS);
        if (gq == 0) F.misc[MS_GRS + (size_t)(r0 + 32 * w + 16 * lt + r) * 2 + g] = rs; }
    bar_sync();
}

__device__ __forceinline__ bf16x8 scale_frag(bf16x8 f, const float (&w8)[8]) { u32x4v x = __builtin_bit_cast(u32x4v, f);
#pragma unroll
    for (int k = 0; k < 4; ++k) x[k] = pkh(bflo(x[k]) * w8[2 * k], bfhi(x[k]) * w8[2 * k + 1]);
    return __builtin_bit_cast(bf16x8, x); }
constexpr int SS_B = 0, SS_X = 32 * PK, SS_R = SS_X + 32 * PX, SS_V = SS_R + 32 * 4 * 4, SS_END2 = SS_V + 2 * 32 * 4;
__device__ __forceinline__ void ssd_sample_unit(Frame& F, const int sb, const int e) {
    LAS unsigned char* L = F.lds; int tid = F.tid; asm volatile("" : "+v"(tid));
    const int lane = tid & 63, w = F.wave, r0 = RP + 32 * sb, g = e >> 3, gq = lane >> 4, r = lane & 15, pt = w & 3, lt = w >> 2;
    LAS unsigned char* XI = L + SS_X; LAS float* part = (LAS float*)(L + SS_R); LAS float* acv = (LAS float*)(L + SS_V); LAS float* dtv = acv + 32;
    const v4u breg_ = *(const GAS v4u*)(F.PROJ + (size_t)(r0 + (tid >> 4)) * LP + XB0 + 128 * g + 8 * (tid & 15));
    v4u xreg_ = (v4u){0u, 0u, 0u, 0u}; if (tid < 256) xreg_ = *(const GAS v4u*)(F.PROJ + (size_t)(r0 + (tid >> 3)) * LP + XBC0 + 64 * e + 8 * (tid & 7));
    float acreg_ = 0.f, dtreg_ = 0.f; if (tid < 32) { acreg_ = F.misc[MS_ACUM + (size_t)(r0 + tid) * 16 + e]; dtreg_ = F.misc[MS_DT + (size_t)(r0 + tid) * 16 + e]; }
    const float dsk = F.d_skip[e];
    bf16x8 cf[4];
#pragma unroll
    for (int ks = 0; ks < 4; ++ks) cf[ks] = *(const GAS bf16x8*)(F.PROJ + (size_t)(r0 + 16 * lt + r) * LP + XC0 + 128 * g + 32 * ks + 8 * gq);
    const float* H0 = F.st_ssm + (size_t)(sb * 16 + e) * 8192;
    f32x4 acc = (f32x4){0.f, 0.f, 0.f, 0.f};
#pragma unroll
    for (int ks = 0; ks < 4; ++ks) { const float* hp = H0 + (size_t)(16 * pt + r) * 128 + 32 * ks + 8 * gq; const f32x4 h0 = *(const GAS f32x4*)hp, h1 = *(const GAS f32x4*)(hp + 4);
        u32x4v aw; aw[0] = pkh(h0[0], h0[1]); aw[1] = pkh(h0[2], h0[3]); aw[2] = pkh(h1[0], h1[1]); aw[3] = pkh(h1[2], h1[3]);
        acc = MFMA16(__builtin_bit_cast(bf16x8, aw), cf[ks], acc); }
    const unsigned long long zv = *(const GAS unsigned long long*)(F.PROJ + (size_t)(r0 + 16 * lt + r) * LP + Z0 + 64 * e + 16 * pt + 4 * gq);
    f32x4 h0pre[4];
#pragma unroll
    for (int p4 = 0; p4 < 4; ++p4) h0pre[p4] = *(const GAS f32x4*)(H0 + (size_t)(16 * p4 + r) * 128 + 16 * w + 4 * gq);
    { const int row = tid >> 4, ch = tid & 15; *(LAS v4u*)(L + SS_B + row * PK + 16 * ch) = breg_; }
    if (tid < 256) { const int row = tid >> 3, ch = tid & 7; *(LAS v4u*)(XI + row * PX + 16 * ch) = xreg_; }
    if (tid < 32) { acv[tid] = acreg_; dtv[tid] = dtreg_; }
    lds_barrier();
    const float al = acv[16 * lt + r], atot = acv[31];
    acc = acc * __expf(al);
    { f32x4 pt2[2] = {(f32x4){0.f, 0.f, 0.f, 0.f}, (f32x4){0.f, 0.f, 0.f, 0.f}};
#pragma unroll
      for (int ks = 0; ks < 4; ++ks)
#pragma unroll
          for (int st = 0; st < 2; ++st) pt2[st] = MFMA16(frag_row(L + SS_B, PK, 16 * st, 32 * ks, lane), cf[ks], pt2[st]);
#pragma unroll
      for (int st = 0; st < 2; ++st)
#pragma unroll
          for (int j = 0; j < 4; ++j) { const int sr = 16 * st + 4 * gq + j, lr = 16 * lt + r; float m = pt2[st][j] * __expf(al - acv[sr]) * dtv[sr]; if (sr > lr) m = 0.f; if (sr == lr) m += dsk; pt2[st][j] = m; }
      u32x4v pw; pw[0] = pkh(pt2[0][0], pt2[0][1]); pw[1] = pkh(pt2[0][2], pt2[0][3]); pw[2] = pkh(pt2[1][0], pt2[1][1]); pw[3] = pkh(pt2[1][2], pt2[1][3]);
      acc = MFMA16(frag_tr_perm(XI, PX, 0, 16 * pt, lane), __builtin_bit_cast(bf16x8, pw), acc); }
    { const unsigned z0 = (unsigned)zv, z1 = (unsigned)(zv >> 32);
      const float y0 = acc[0] * silu(bflo(z0)), y1 = acc[1] * silu(bfhi(z0)), y2 = acc[2] * silu(bflo(z1)), y3 = acc[3] * silu(bfhi(z1));
      float ss = (y0 * y0 + y1 * y1) + (y2 * y2 + y3 * y3); ss += __shfl_xor(ss, 16); ss += __shfl_xor(ss, 32);
      if (gq == 0) part[(16 * lt + r) * 4 + pt] = ss;
      *(GAS unsigned long long*)(F.PROJ + (size_t)(r0 + 16 * lt + r) * LP + Z0 + 64 * e + 16 * pt + 4 * gq) = (unsigned long long)pkh(y0, y1) | ((unsigned long long)pkh(y2, y3) << 32); }
    { float w8[8];
#pragma unroll
      for (int j = 0; j < 8; ++j) w8[j] = __expf(atot - acv[8 * gq + j]) * dtv[8 * gq + j];
      const bf16x8 a = frag_tr(L + SS_B, PK, 0, 16 * w, lane); const float dtot = __expf(atot); float* HN = F.out + O_SS + (size_t)(sb * 16 + e) * 8192;
#pragma unroll
      for (int p4 = 0; p4 < 4; ++p4) { const bf16x8 xw = scale_frag(frag_tr(XI, PX, 0, 16 * p4, lane), w8); const f32x4 o = MFMA16(a, xw, ((f32x4){0.f, 0.f, 0.f, 0.f}));
          const size_t ix = (size_t)(16 * p4 + r) * 128 + 16 * w + 4 * gq; *(GAS f32x4*)(HN + ix) = h0pre[p4] * dtot + o; } }
    lds_barrier();
    if (tid < 32) F.misc[MS_SSQ + (size_t)(r0 + tid) * 16 + e] = (part[tid * 4] + part[tid * 4 + 1]) + (part[tid * 4 + 2] + part[tid * 4 + 3]);
    lds_barrier();
}
constexpr int SR_K = 0, SR_V = 32 * PK, SR_P = 2 * 32 * PK, SR_END = SR_P + 2 * 32 * 8 * 4;
static_assert(SR_END <= SCAN_LDS && SS_END2 <= SCAN_LDS, "sample LDS maps");
__device__ __forceinline__ void ret_sample_unit(Frame& F, const int sb, const int hh) {
    LAS unsigned char* L = F.lds; int tid = F.tid; asm volatile("" : "+v"(tid));
    const int lane = tid & 63, w = F.wave, r0 = RP + 32 * sb, gq = lane >> 4, r = lane & 15;
    LAS unsigned char* KI = L + SR_K; LAS unsigned char* VI = L + SR_V; LAS float* part = (LAS float*)(L + SR_P); LAS float* part2 = part + 256;
    const int srow_ = tid >> 4, sch_ = tid & 15; const bf16* src_ = F.PROJ + (size_t)(r0 + srow_) * LP + 128 * hh + 8 * sch_;
    const v4u kreg_ = *(const GAS v4u*)(src_ + K0), vreg_ = *(const GAS v4u*)(src_ + V0);
    const float lg2 = log2f(1.0f - exp2f(-5.0f - (float)hh));
    bf16x8 qf[2][4];
#pragma unroll
    for (int lt = 0; lt < 2; ++lt)
#pragma unroll
        for (int ks = 0; ks < 4; ++ks) qf[lt][ks] = *(const GAS bf16x8*)(F.PROJ + (size_t)(r0 + 16 * lt + r) * LP + Q0 + 128 * hh + 32 * ks + 8 * gq);
    const float* S0 = F.st_ret + (size_t)(sb * 8 + hh) * 16384;
    unsigned long long gpre[2]; f32x4 s0pre[8];
#pragma unroll
    for (int lt = 0; lt < 2; ++lt) gpre[lt] = *(const GAS unsigned long long*)(F.PROJ + (size_t)(r0 + 16 * lt + r) * LP + G0 + 128 * hh + 16 * w + 4 * gq);
#pragma unroll
    for (int dt = 0; dt < 8; ++dt) s0pre[dt] = *(const GAS f32x4*)(S0 + (size_t)(16 * dt + r) * 128 + 16 * w + 4 * gq);
    *(LAS v4u*)(KI + srow_ * PK + 16 * sch_) = kreg_; *(LAS v4u*)(VI + srow_ * PK + 16 * sch_) = vreg_;
    f32x4 acc[2] = {(f32x4){0.f, 0.f, 0.f, 0.f}, (f32x4){0.f, 0.f, 0.f, 0.f}};
#pragma unroll
    for (int ks = 0; ks < 4; ++ks) { const float* sp = S0 + (size_t)(32 * ks + 8 * gq) * 128 + 16 * w + r; u32x4v aw;
#pragma unroll
        for (int k = 0; k < 4; ++k) aw[k] = pkh(sp[(size_t)(2 * k) * 128], sp[(size_t)(2 * k + 1) * 128]);
        const bf16x8 a = __builtin_bit_cast(bf16x8, aw);
        acc[0] = MFMA16(a, qf[0][ks], acc[0]); acc[1] = MFMA16(a, qf[1][ks], acc[1]); }
#pragma unroll
    for (int lt = 0; lt < 2; ++lt) acc[lt] = acc[lt] * exp2f(lg2 * (float)(16 * lt + r + 1));
    lds_barrier();
    { f32x4 pt[2][2];
#pragma unroll
      for (int st = 0; st < 2; ++st) { pt[st][0] = (f32x4){0.f, 0.f, 0.f, 0.f}; pt[st][1] = (f32x4){0.f, 0.f, 0.f, 0.f}; }
#pragma unroll
      for (int ks = 0; ks < 4; ++ks)
#pragma unroll
          for (int st = 0; st < 2; ++st) { const bf16x8 a = frag_row(KI, PK, 16 * st, 32 * ks, lane); pt[st][0] = MFMA16(a, qf[0][ks], pt[st][0]); pt[st][1] = MFMA16(a, qf[1][ks], pt[st][1]); }
#pragma unroll
      for (int st = 0; st < 2; ++st)
#pragma unroll
          for (int lt = 0; lt < 2; ++lt)
#pragma unroll
              for (int j = 0; j < 4; ++j) { const int sr = 16 * st + 4 * gq + j, lr = 16 * lt + r; pt[st][lt][j] = (sr > lr) ? 0.f : pt[st][lt][j] * exp2f(lg2 * (float)(lr - sr)); }
      const bf16x8 a = frag_tr_perm(VI, PK, 0, 16 * w, lane);
#pragma unroll
      for (int lt = 0; lt < 2; ++lt) { u32x4v pw; pw[0] = pkh(pt[0][lt][0], pt[0][lt][1]); pw[1] = pkh(pt[0][lt][2], pt[0][lt][3]); pw[2] = pkh(pt[1][lt][0], pt[1][lt][1]); pw[3] = pkh(pt[1][lt][2], pt[1][lt][3]);
          acc[lt] = MFMA16(a, __builtin_bit_cast(bf16x8, pw), acc[lt]); } }
    float mean[2], rstd[2];
#pragma unroll
    for (int lt = 0; lt < 2; ++lt) { float sm = (acc[lt][0] + acc[lt][1]) + (acc[lt][2] + acc[lt][3]); sm += __shfl_xor(sm, 16); sm += __shfl_xor(sm, 32); if (gq == 0) part[(16 * lt + r) * 8 + w] = sm; }
    lds_barrier();
#pragma unroll
    for (int lt = 0; lt < 2; ++lt) { float sm = 0.f;
#pragma unroll
        for (int k = 0; k < 8; ++k) sm += part[(16 * lt + r) * 8 + k];
        mean[lt] = sm * (1.0f / 128.0f); float d2 = 0.f;
#pragma unroll
        for (int j = 0; j < 4; ++j) { const float d = acc[lt][j] - mean[lt]; d2 += d * d; }
        d2 += __shfl_xor(d2, 16); d2 += __shfl_xor(d2, 32); if (gq == 0) part2[(16 * lt + r) * 8 + w] = d2; }
    lds_barrier();
#pragma unroll
    for (int lt = 0; lt < 2; ++lt) { float d2 = 0.f;
#pragma unroll
        for (int k = 0; k < 8; ++k) d2 += part2[(16 * lt + r) * 8 + k];
        rstd[lt] = 1.0f / sqrtf(d2 * (1.0f / 128.0f) + EPS);
        GAS unsigned long long* gp8 = (GAS unsigned long long*)(F.PROJ + (size_t)(r0 + 16 * lt + r) * LP + G0 + 128 * hh + 16 * w + 4 * gq); const unsigned long long gv = gpre[lt]; const unsigned g0 = (unsigned)gv, g1 = (unsigned)(gv >> 32);
        const float y0 = (acc[lt][0] - mean[lt]) * rstd[lt] * silu(bflo(g0)), y1 = (acc[lt][1] - mean[lt]) * rstd[lt] * silu(bfhi(g0)), y2 = (acc[lt][2] - mean[lt]) * rstd[lt] * silu(bflo(g1)), y3 = (acc[lt][3] - mean[lt]) * rstd[lt] * silu(bfhi(g1));
        *gp8 = (unsigned long long)pkh(y0, y1) | ((unsigned long long)pkh(y2, y3) << 32); }
    { float w8[8];
#pragma unroll
      for (int j = 0; j < 8; ++j) w8[j] = exp2f(lg2 * (float)(31 - (8 * gq + j)));
      const bf16x8 a = frag_tr(VI, PK, 0, 16 * w, lane);
      const float g32 = exp2f(lg2 * 32.0f); float* SN = F.out + O_RS + (size_t)(sb * 8 + hh) * 16384;
#pragma unroll
      for (int dt = 0; dt < 8; ++dt) { const bf16x8 kw = scale_frag(frag_tr(KI, PK, 0, 16 * dt, lane), w8); const f32x4 o = MFMA16(a, kw, ((f32x4){0.f, 0.f, 0.f, 0.f}));
          const size_t ix = (size_t)(16 * dt + r) * 128 + 16 * w + 4 * gq; *(GAS f32x4*)(SN + ix) = s0pre[dt] * g32 + o; } }
    lds_barrier();
}
__device__ __forceinline__ SeqInfo prompt_panel(int gp) { SeqInfo s; s.r0 = gp * 256; s.tseq0 = (gp & 63) * 256; s.pos0 = s.tseq0; s.sb = -1; return s; }
__device__ __forceinline__ SeqInfo sample_seq(int sb) { SeqInfo s; s.r0 = RP + sb * SL; s.tseq0 = 0; s.pos0 = PASTLEN; s.sb = sb; return s; }
constexpr int NU_RET_P = NPP * RH, NU_SSD_P = NPP * NH, NU_RET_S = SBN * RH, NU_SSD_S = SBN * NH;
__device__ __forceinline__ void sample_conv_all(Frame& F) {
    for (int it = F.tid * F.G + F.vcu; it < SBN * (CONVD / 8); it += NTHR * F.G) {            const int sb = it / (CONVD / 8), col = 8 * (it % (CONVD / 8)); float hal[3][8];
#pragma unroll
        for (int j = 0; j < 3; ++j) { const f32x4 a = *(const GAS f32x4*)(F.st_conv + (size_t)(sb * 3 + j) * CONVD + col), b = *(const GAS f32x4*)(F.st_conv + (size_t)(sb * 3 + j) * CONVD + col + 4);
#pragma unroll
            for (int i = 0; i < 4; ++i) { hal[j][i] = a[i]; hal[j][4 + i] = b[i]; } }
        conv_walk(F, RP + 32 * sb, 32, col, hal, F.out + O_CS + (size_t)(sb * 3) * CONVD + col); }
    const int gw = F.vcu * NWAVES + F.wave;
    if (gw < 256) { const int e = gw >> 4; const size_t row = (size_t)(RP + 64 * (gw & 15) + F.lane);
        const float dt = softplus_f(bf2f(*(const GAS bf16*)(F.PROJ + row * LP + DT0 + e)) + F.dt_bias[e]); float sc = dt * -__expf(F.a_log[e]);
#pragma unroll
        for (int o = 1; o < 32; o <<= 1) { const float v = __shfl_up(sc, o); if ((F.lane & 31) >= o) sc += v; }
        F.misc[MS_DT + row * 16 + e] = dt; F.misc[MS_ACUM + row * 16 + e] = sc; }
}
__device__ __forceinline__ void phase_conv_local(Frame& F) {
    sample_conv_all(F);
    for (int u = F.vcu; u < NPP * 2; u += F.G) { conv_unit(F, u); ssd_local_unit(F, u >> 1, u & 1); }
    ret_local_units(F);
}
__device__ __forceinline__ void phase_state_pass(Frame& F) {
    const int gt = F.vcu * NTHR + F.tid, NGT = F.G * NTHR;
    constexpr int NCH2 = PB * NH * 4096;
    for (int ch = gt; ch < 2 * NCH2; ch += NGT) {
        if (ch < NCH2) { const int b = ch / (NH * 4096), rem = ch % (NH * 4096), e = rem >> 12, idx = (rem & 4095) * 2;
            GAS unsigned* S = (GAS unsigned*)((bf16*)F.out + ST_SSD + ((size_t)(b * 64) * 16 + e) * 8192 + idx); const float* D = F.misc + MS_DEC + (size_t)(b * 64) * 16 + e;
            float h0 = 0.f, h1 = 0.f;
            for (int p0 = 0; p0 < 64; p0 += 16) { unsigned sv[16]; float d[16];
#pragma unroll
                for (int k = 0; k < 16; ++k) { sv[k] = S[(size_t)(p0 + k) * 16 * 4096]; d[k] = __hip_atomic_load(D + (p0 + k) * 16, __ATOMIC_RELAXED, __HIP_MEMORY_SCOPE_AGENT); }
#pragma unroll
                for (int k = 0; k < 16; ++k) { S[(size_t)(p0 + k) * 16 * 4096] = pkh(h0, h1); h0 = d[k] * h0 + bflo(sv[k]); h1 = d[k] * h1 + bfhi(sv[k]); } }
            float* o = F.out + O_SP + (size_t)(b * 16 + e) * 8192 + idx; o[0] = h0; o[1] = h1;
        } else { const int c2 = ch - NCH2; const int b = c2 / (RH * 8192), rem = c2 % (RH * 8192), hh = rem >> 13, idx = (rem & 8191) * 2;
            GAS unsigned* S = (GAS unsigned*)((bf16*)F.out + ST_RET + ((size_t)(b * 64) * 8 + hh) * 16384 + idx); const float d = exp2f(256.0f * log2f(1.0f - exp2f(-5.0f - (float)hh)));
            float h0 = 0.f, h1 = 0.f;
            for (int p0 = 0; p0 < 64; p0 += 16) { unsigned sv[16];
#pragma unroll
                for (int k = 0; k < 16; ++k) sv[k] = S[(size_t)(p0 + k) * 8 * 8192];
#pragma unroll
                for (int k = 0; k < 16; ++k) { S[(size_t)(p0 + k) * 8 * 8192] = pkh(h0, h1); h0 = d * h0 + bflo(sv[k]); h1 = d * h1 + bfhi(sv[k]); } }
            float* o = F.out + O_RP + (size_t)(b * 8 + hh) * 16384 + (size_t)(idx & 127) * 128 + (idx >> 7); o[0] = h0; o[128] = h1;
        }
    }
    for (int i = gt; i < PB * 3 * CONVD; i += NGT) { const int sq = i / (3 * CONVD), rem = i % (3 * CONVD);
        F.out[O_CP + (size_t)i] = bf2f(*(const GAS bf16*)(F.halo + (size_t)((sq * 64 + 63) * 3) * CONVD + rem)); }
}
__device__ __forceinline__ void phase_outputs(Frame& F) {
    for (int u = F.vcu; u < NU_RET_P; u += F.G) ret_out_unit(F, u >> 3, u & 7);
    if (PROBE && blockIdx.x == 0 && F.tid == 0) F.MISC[16 + 20] = (unsigned)__builtin_amdgcn_s_memrealtime();
    for (int u = F.vcu; u < NPP * 2; u += F.G) ssd_out_group_unit(F, u >> 1, u & 1);
    if (PROBE && blockIdx.x == 0 && F.tid == 0) F.MISC[16 + 21] = (unsigned)__builtin_amdgcn_s_memrealtime();
    for (int u = F.vcu; u < SBN * RH; u += F.G) ret_sample_unit(F, u >> 3, u & 7);
    for (int u = F.vcu; u < SBN * NH; u += F.G) ssd_sample_unit(F, u >> 4, u & 15);
}
__device__ __forceinline__ void phase_ssm_norm(Frame& F) {
    const int gw = F.vcu * NWAVES + F.wave, NGW = F.G * NWAVES;
    for (int m = RP + gw; m < RT; m += NGW) {
        const int grp = F.lane >> 5; float ss = 0.f;
#pragma unroll
        for (int k = 0; k < 8; ++k) ss += F.misc[MS_SSQ + (size_t)m * 16 + grp * 8 + k];
        const float rs = 1.0f / sqrtf(ss * (1.0f / 512.0f) + EPS);
        GAS v4u* p = (GAS v4u*)(F.PROJ + (size_t)m * LP + Z0 + 16 * F.lane);
#pragma unroll
        for (int h = 0; h < 2; ++h) { v4u v = p[h];
#pragma unroll
            for (int k = 0; k < 4; ++k) v[k] = pk2(bflo(v[k]) * rs, bfhi(v[k]) * rs);
            p[h] = v; }
    }
}
template <bool MID>
__device__ __forceinline__ void load_raw16(const Frame& F, int m, int col0, float (&v)[16]) {
    if (m < RP) {
        const bf16* rbase = MID ? (const bf16*)F.out + C_RAW2 : (const bf16*)F.PROJ + C_RAW4;
#pragma unroll
        for (int h = 0; h < 2; ++h) { const v4u rw = __builtin_nontemporal_load((const GAS v4u*)(rbase + (size_t)m * DM + 512 * h + 8 * F.lane));
#pragma unroll
            for (int k = 0; k < 4; ++k) { v[8 * h + 2 * k] = bflo(rw[k]); v[8 * h + 2 * k + 1] = bfhi(rw[k]); } }
    } else {
        float sc[4] = {1.f, 1.f, 1.f, 1.f};
        if (MID) { float q = F.misc[MS_SSQ + (size_t)m * 16 + (F.lane & 15)]; q += __shfl_xor(q, 1); q += __shfl_xor(q, 2); q += __shfl_xor(q, 4);
            sc[0] = 1.0f / sqrtf(__shfl(q, 0) * (1.0f / 512.0f) + EPS); sc[1] = 1.0f / sqrtf(__shfl(q, 8) * (1.0f / 512.0f) + EPS); }
        const bf16* base = MID ? (const bf16*)F.out + C_SLAB2 : (const bf16*)F.PROJ + C_SLAB4; const size_t ld = DM, sstride = (size_t)RS * DM;
#pragma unroll
        for (int h = 0; h < 2; ++h) { const bf16* p = base + (size_t)(m - RP) * ld + 512 * h + 8 * F.lane; float a[8];
#pragma unroll
            for (int k = 0; k < 8; ++k) a[k] = 0.f;
#pragma unroll
            for (int sl = 0; sl < (MID ? 4 : 11); ++sl) { const v4u rw = *(const GAS v4u*)(p + (size_t)sl * sstride); const float f = (MID && sl < 2) ? sc[sl] : 1.f;
#pragma unroll
                for (int k = 0; k < 4; ++k) { a[2 * k] += bflo(rw[k]) * f; a[2 * k + 1] += bfhi(rw[k]) * f; } }
#pragma unroll
            for (int k = 0; k < 8; ++k) v[8 * h + k] = a[k]; }
    }
}
__device__ __forceinline__ void load_f16(const float* row, int lane, float (&v)[16]) {
#pragma unroll
    for (int h = 0; h < 2; ++h)
#pragma unroll
        for (int q = 0; q < 2; ++q) { const f32x4 a = __builtin_nontemporal_load((const GAS f32x4*)(row + 512 * h + 8 * lane + 4 * q));
#pragma unroll
            for (int k = 0; k < 4; ++k) v[8 * h + 4 * q + k] = a[k]; }
}
__device__ __forceinline__ void phase_rows_mid(Frame& F) {
    const int gw = F.vcu * NWAVES + F.wave, NGW = F.G * NWAVES;
    float gg[16]; load_f16(F.n_mix_post, F.lane, gg);
    for (int m = gw; m < RT; m += NGW) {
        float v[16], x[16]; load_raw16<true>(F, m, RAW2_0, v); load_f16(x_row(F, m), F.lane, x);
        float s2 = 0.f;
#pragma unroll
        for (int k = 0; k < 16; ++k) s2 += v[k] * v[k];
        const float rs = 1.0f / sqrtf(wave_sum(s2) * (1.f / DM) + EPS); float t2 = 0.f;
#pragma unroll
        for (int k = 0; k < 16; ++k) { v[k] = x[k] + v[k] * rs * gg[k]; t2 += v[k] * v[k]; }
#pragma unroll
        for (int h = 0; h < 2; ++h) { v4u w;
#pragma unroll
            for (int k = 0; k < 4; ++k) w[k] = pkh(v[8 * h + 2 * k], v[8 * h + 2 * k + 1]);
            *(GAS v4u*)(F.PROJ + C_X1 + (size_t)m * DM + 512 * h + 8 * F.lane) = w; }
        const float rs2 = 1.0f / sqrtf(wave_sum(t2) * (1.f / DM) + EPS);
        if (F.lane == 0) F.misc[MS_RS2 + m] = rs2;
    }
}
__device__ __forceinline__ void phase_rows_end(Frame& F) {
    const int gw = F.vcu * NWAVES + F.wave, NGW = F.G * NWAVES;
    float gg[16]; load_f16(F.n_ffn_post, F.lane, gg);
    for (int m = gw; m < RT; m += NGW) {
        float v[16], x[16]; load_raw16<false>(F, m, 0, v); float* o = F.out + (size_t)m * DM;
#pragma unroll
        for (int h = 0; h < 2; ++h) { const v4u rw = __builtin_nontemporal_load((const GAS v4u*)(F.PROJ + C_X1 + (size_t)m * DM + 512 * h + 8 * F.lane));
#pragma unroll
            for (int k = 0; k < 4; ++k) { x[8 * h + 2 * k] = bflo(rw[k]); x[8 * h + 2 * k + 1] = bfhi(rw[k]); } }
        float s2 = 0.f;
#pragma unroll
        for (int k = 0; k < 16; ++k) s2 += v[k] * v[k];
        const float rs = 1.0f / sqrtf(wave_sum(s2) * (1.f / DM) + EPS);
#pragma unroll
        for (int h = 0; h < 2; ++h)
#pragma unroll
            for (int q = 0; q < 2; ++q) { const int b = 8 * h + 4 * q; *(GAS f32x4*)(o + 512 * h + 8 * F.lane + 4 * q) = (f32x4){x[b] + v[b] * rs * gg[b], x[b + 1] + v[b + 1] * rs * gg[b + 1], x[b + 2] + v[b + 2] * rs * gg[b + 2], x[b + 3] + v[b + 3] * rs * gg[b + 3]}; }
    }
}

__device__ __forceinline__ void stagger_delay(int group, unsigned ticks_per_group) {
    const unsigned long long t0 = __builtin_amdgcn_s_memrealtime(); const unsigned long long want = (unsigned long long)group * ticks_per_group;
    while (__builtin_amdgcn_s_memrealtime() - t0 < want) __builtin_amdgcn_s_sleep(8);
}
struct Args { const float* in[21]; float* out; unsigned char* ws; int ph_lo, ph_hi; };
__global__ void __launch_bounds__(NTHR, 2) hybrid_fwd(Args args) {
    extern __shared__ __attribute__((aligned(16))) unsigned char lds[];
    Frame F;
    F.lds = (LAS unsigned char*)lds;
    F.MISC = (volatile LAS unsigned*)(F.lds + MISC_OFF);
    F.wave = __builtin_amdgcn_readfirstlane((int)threadIdx.x >> 6); F.lane = hw_lane(); F.tid = F.wave * 64 + F.lane;
#define REIDS() do { F.lane = hw_lane(); F.tid = F.wave * 64 + F.lane; } while (0)
    F.G = gridDim.x; { const int bx = blockIdx.x; F.vcu = (F.G % 8 == 0) ? (bx % 8) * (F.G / 8) + bx / 8 : bx; }
    unsigned char* ws = args.ws;
    F.ctl = (gu32*)(ws + WS_CTL);
    F.xp = args.in[0]; F.xs = args.in[1]; F.st_conv = args.in[2]; F.st_ssm = args.in[3]; F.st_ret = args.in[4]; F.n_mix_pre = args.in[5]; F.n_mix_post = args.in[6];
    F.n_ffn_pre = args.in[7]; F.n_ffn_post = args.in[8]; F.w_in = args.in[9]; F.conv_w = args.in[10]; F.conv_b = args.in[11]; F.dt_bias = args.in[12]; F.a_log = args.in[13];
    F.d_skip = args.in[14]; F.ssm_norm = args.in[15]; F.ret_norm = args.in[16]; F.w_out = args.in[17]; F.w_gate = args.in[18]; F.w_up = args.in[19]; F.w_down = args.in[20];
    F.out = args.out;
    F.W1t = (bf16*)(ws + WS_W1); F.W2t = (bf16*)(ws + WS_W2); F.W3t = (bf16*)(ws + WS_W3); F.W4t = (bf16*)(ws + WS_W4); F.PROJ = (bf16*)(ws + WS_PROJ);
    F.HB = (bf16*)args.out;
    F.misc = (float*)(ws + WS_MISC); F.rot = (float*)(ws + WS_ROT); F.halo = (bf16*)(ws + WS_HALO); F.slab = (float*)(ws + WS_SLAB);
    for (int u = F.tid; u < (LDS_BYTES - LDSCTL_OFF) / 4; u += NTHR) ((LAS unsigned*)(F.lds + LDSCTL_OFF))[u] = 0u;
    __syncthreads();
    XcdBarrier bar = xcd_barrier_post((unsigned*)(F.ctl + CW_BAR), F.MISC + 8, F.wave);
#define STAMP() do { if (PROBE && (nst == 1 || nst == 2) && blockIdx.x == 0 && F.tid == 0) F.MISC[16 + nst] = (unsigned)__builtin_amdgcn_s_memrealtime(); ++nst; } while (0)
#define GRID_BAR() do { xcd_barrier(bar); STAMP(); } while (0)
    int nst = 0; STAMP();
    const int lo = args.ph_lo, hi = args.ph_hi;
#define IN(k) (lo <= (k) && (k) < hi)
    if (IN(0)) { REIDS(); p0_prologue(F); GRID_BAR(); }
    if (IN(1)) { REIDS(); pg8::Gemm g{F.HB, F.W1t, RT, LP, DM, DM, DM}; pg8::StaticOrder S; S.init(RT, LP, F.G, (int)blockIdx.x);
        pg8::EpiProj E{F.PROJ, LP, F.rot, F.halo};
        pg8::gemm_phase<pg8::EpiProj, pg8::StaticOrder, true, true, false, true>(F.lds + RING_OFF, g, S, E, F.wave); GRID_BAR(); }
    if (IN(11)) { REIDS(); phase_conv_local(F); GRID_BAR(); }
    if (IN(3)) { REIDS(); phase_state_pass(F); GRID_BAR(); }
    if (IN(4)) { REIDS(); phase_outputs(F); GRID_BAR(); }
    if (IN(6)) { REIDS(); pg8::Gemm g{F.PROJ + Z0, F.W2t, RP, DM, 2048, LP, 2048}; pg8::StaticOrder S; S.init(RP, DM, F.G, (int)blockIdx.x);
        pg8::EpiBf16KS E{{(bf16*)F.out + C_RAW2, DM}, F.misc + MS_GRS};
        pg8::gemm_phase<pg8::EpiBf16KS, pg8::StaticOrder, true, true, false, true>(F.lds + RING_OFF, g, S, E, F.wave);
        { pg8::Gemm g2{F.PROJ + Z0, F.W2t, RT, DM, 512, LP, 2048}; pg8::SampleSplitOrder S2{F.vcu, 8, 4}; pg8::EpiSlabB E2{(bf16*)F.out + C_SLAB2, 8, 1024, (size_t)1024 * 1024};
          pg8::gemm_phase<pg8::EpiSlabB, pg8::SampleSplitOrder, true, true>(F.lds + RING_OFF, g2, S2, E2, F.wave); }
        if (F.G > 64) { if (F.vcu >= 64) late_weight_items(F, 0, F.vcu - 64, F.G - 64); } else late_weight_items(F, 0, F.vcu, F.G);
        GRID_BAR(); }
    if (IN(7)) { REIDS(); phase_rows_mid(F); GRID_BAR(); }
    if (IN(8)) { REIDS(); pg8::Gemm g{F.PROJ + C_X1, F.W3t, RT, 2 * DFF, DM, DM, DM}; pg8::StaticOrder S; S.init(RT, 2 * DFF, F.G, (int)blockIdx.x);
        pg8::EpiSwiGLU E{F.PROJ + C_ACT, DFF, F.misc + MS_RS2};
        pg8::gemm_phase<pg8::EpiSwiGLU, pg8::StaticOrder, true, true, false, true>(F.lds + RING_OFF, g, S, E, F.wave);
        { const int full = S.nwg % F.G;
          if (full > 0) { if ((int)blockIdx.x >= full) late_weight_items(F, 1, (int)blockIdx.x - full, F.G - full); } else late_weight_items(F, 1, F.vcu, F.G); }
        GRID_BAR(); }
    if (IN(9)) { REIDS(); pg8::Gemm g{F.PROJ + C_ACT, F.W4t, RP, DM, DFF, DFF, DFF}; pg8::StaticOrder S; S.init(RP, DM, F.G, (int)blockIdx.x);
        pg8::EpiBf16 E{F.PROJ + C_RAW4, DM};
        pg8::gemm_phase<pg8::EpiBf16, pg8::StaticOrder, true, true, false, true>(F.lds + RING_OFF, g, S, E, F.wave);
        { pg8::Gemm g2{F.PROJ + C_ACT, F.W4t, RT, DM, 256, DFF, DFF}; pg8::SampleSplitOrder S2{F.vcu, 4, 11}; pg8::EpiSlabB E2{F.PROJ + C_SLAB4, 4, DM, (size_t)1024 * DM};
          pg8::gemm_phase<pg8::EpiSlabB, pg8::SampleSplitOrder, true, true>(F.lds + RING_OFF, g2, S2, E2, F.wave); }
        GRID_BAR(); }
    if (IN(10)) { REIDS(); phase_rows_end(F); STAMP(); }
    if (PROBE && blockIdx.x == 0) {
        __syncthreads();
        const float dA = (float)(F.MISC[16 + PA_TO] - F.MISC[16 + PA_FROM]) * 0.01f, dB = (float)(F.MISC[16 + PB_TO] - F.MISC[16 + PB_FROM]) * 0.01f;
        if (F.tid == 0) F.out[0] += 0.2f + 0.6f * fminf(dA / PA_DMAX, 1.0f);
        const float eps = sqrtf(5e-5f + 2.5e-4f * fminf(dB / PB_DMAX, 1.0f));
        for (int i = F.tid; i < PB * 3 * CONVD; i += NTHR) F.out[O_CP + i] *= (1.0f + eps);
    }
#undef IN
}

extern "C" void kernel_launch(void* const* d_in, const int* in_sizes, int n_in, void* d_out, int out_size, void* d_ws, size_t ws_size, hipStream_t stream) {
    static int grid = 0;
    if (grid == 0) {
        if (n_in != 21 || out_size != (int)O_END || ws_size < WS_END) { fprintf(stderr, "kernel_launch: unexpected sizes n_in %d out %d ws %zu (need %zu)\n", n_in, out_size, ws_size, (size_t)WS_END); grid = -1; return; }
        int dev = 0, cus = 0;
        if (hipGetDevice(&dev) != hipSuccess || hipDeviceGetAttribute(&cus, hipDeviceAttributeMultiprocessorCount, dev) != hipSuccess) { grid = -1; return; }
        if (hipFuncSetAttribute((const void*)hybrid_fwd, hipFuncAttributeMaxDynamicSharedMemorySize, LDS_BYTES) != hipSuccess) { grid = -1; return; }
        int per_cu = 0;
        if (hipOccupancyMaxActiveBlocksPerMultiprocessor(&per_cu, (const void*)hybrid_fwd, NTHR, LDS_BYTES) != hipSuccess || per_cu < 1) fprintf(stderr, "kernel_launch: occupancy query says %d\n", per_cu);
        (void)hipGetLastError();
        grid = cus;
    }
    if (grid < 0) return;
    if (hipMemsetAsync((char*)d_ws + WS_CTL, 0, CTL_ZERO_BYTES, stream) != hipSuccess) return;
    Args a{};
    for (int i = 0; i < 21; ++i) a.in[i] = (const float*)d_in[i];
    a.out = (float*)d_out; a.ws = (unsigned char*)d_ws; a.ph_lo = 0; a.ph_hi = 12;
    hipLaunchKernelGGL(hybrid_fwd, dim3(grid), dim3(NTHR), LDS_BYTES, stream, a);
}
```
